# Optimizing an MI355X kernel written in HIP

```python
import jax
import jax.numpy as jnp
from jax import lax

D_MODEL = 1024
BATCH = 8
SEQ = 4096
DEPTH = 4

GRID_W = 64
CTX_LEN = 256
EPS = 1e-6

GLA_HEADS = 4
GLA_DK = 64
GLA_DV = 128
GLA_QK = GLA_HEADS * GLA_DK
GLA_V = GLA_HEADS * GLA_DV
GLA_RANK = 16
GLA_TAU = 16.0
GLA_CHUNK = 64

FNET_GROUPS = 4
FNET_GD = 64
FNET_W = FNET_GROUPS * FNET_GD

RG_HEADS = 4
RG_HD = 64
RG_W = RG_HEADS * RG_HD
RG_C = 8.0
CONV_W = 4
CONV_LEFT = 1

MIX_W = GLA_V + FNET_W + RG_W
D_FF = -(-8 * D_MODEL // (3 * 256)) * 256

OFF_K = GLA_QK
OFF_V = OFF_K + GLA_QK
OFF_DEC = OFF_V + GLA_V
OFF_OG = OFF_DEC + 2 * GLA_RANK
OFF_F = OFF_OG + GLA_V
OFF_RX = OFF_F + FNET_W
OFF_RG = OFF_RX + RG_W
N_IN = OFF_RG + RG_W
IN_SPLITS = (OFF_K, OFF_V, OFF_DEC, OFF_OG, OFF_F, OFF_RX, OFF_RG)

kernel_name = 'hybrid_gla_fnet_rglru_prefix_dit'


def rmsnorm(x, g):
    xf = x.astype(jnp.float32)
    y = xf * lax.rsqrt(jnp.mean(xf * xf, axis=-1, keepdims=True) + EPS)
    return (y * g.astype(jnp.float32)).astype(x.dtype)


def modulate(h, shift, scale):
    return h * (1 + scale) + shift


def rev(t):
    return jnp.flip(t, axis=1)


def swiglu(h, w_gate, w_up, w_down):
    return (jax.nn.silu(h @ w_gate) * (h @ w_up)) @ w_down


def gla_prepare(z_q, z_k, z_v, z_dec, w_dec, b_dec):
    B, T, _ = z_q.shape
    f32 = jnp.float32
    q = z_q.astype(f32).reshape(B, T, GLA_HEADS, GLA_DK) * (GLA_DK ** -0.5)
    k = z_k.astype(f32).reshape(B, T, GLA_HEADS, GLA_DK)
    v = z_v.astype(f32).reshape(B, T, GLA_HEADS, GLA_DV)
    lr = z_dec.astype(f32).reshape(B, T, 2, GLA_RANK)
    logit = jnp.einsum('btdr,drk->btdk', lr, w_dec.astype(f32)) + b_dec.astype(f32)
    log_a = (jax.nn.log_sigmoid(logit) / GLA_TAU).reshape(B, T, 2, GLA_HEADS, GLA_DK)
    return q, k, v, log_a[:, :, 0], log_a[:, :, 1]


def gla_scan(q, k, v, log_a, s0):
    B, T, H, _ = q.shape
    N = T // GLA_CHUNK

    def chunks(t):
        return t.reshape(B, N, GLA_CHUNK, H, t.shape[-1]).transpose(1, 0, 3, 2, 4)

    qc, kc, vc, gc = chunks(q), chunks(k), chunks(v), chunks(log_a)
    b = jnp.cumsum(gc, axis=3)
    b_last = b[:, :, :, -1:, :]
    q_t = qc * jnp.exp(b)
    k_t = kc * jnp.exp(-b)
    k_end = kc * jnp.exp(b_last - b)
    mask = jnp.tril(jnp.ones((GLA_CHUNK, GLA_CHUNK), dtype=bool))
    attn = jnp.where(mask, jnp.einsum('nbhik,nbhjk->nbhij', q_t, k_t), 0.0)
    o_intra = jnp.einsum('nbhij,nbhjv->nbhiv', attn, vc)

    def step(s, inp):
        q_n, k_n, v_n, d_n = inp
        o_n = jnp.einsum('bhik,bhkv->bhiv', q_n, s)
        s_new = s * d_n[:, :, 0, :, None] + jnp.einsum('bhjk,bhjv->bhkv', k_n, v_n)
        return s_new, o_n

    s_fin, o_inter = lax.scan(step, s0, (q_t, k_end, vc, jnp.exp(b_last)))
    o = (o_intra + o_inter).transpose(1, 0, 3, 2, 4).reshape(B, T, H, v.shape[-1])
    return o, s_fin


def gla_final_state(k, v, log_a):
    b = jnp.cumsum(log_a, axis=1)
    w = jnp.exp(b[:, -1:] - b)
    return jnp.einsum('bthk,bthv->bhkv', k * w, v)


def gla_norm_gate(o, z_og, g_gla):
    B, T = o.shape[:2]
    o = o * lax.rsqrt(jnp.mean(o * o, axis=-1, keepdims=True) + EPS) * g_gla.astype(jnp.float32)
    return o.reshape(B, T, GLA_V) * jax.nn.silu(z_og.astype(jnp.float32))


def fourier_mix(z_f):
    B, T, _ = z_f.shape
    fg = z_f.astype(jnp.float32).reshape(B, T, FNET_GROUPS, FNET_GD)
    y = jnp.fft.fft2(fg, axes=(1, 3), norm='ortho').real
    return y.reshape(B, T, FNET_W)


def short_conv(u, w, b):
    L = u.shape[2]
    up = jnp.pad(u, ((0, 0), (0, 0), (CONV_LEFT, CONV_W - 1 - CONV_LEFT), (0, 0)))
    w = w.astype(jnp.float32)
    out = b.astype(jnp.float32)
    for j in range(CONV_W):
        out = out + up[:, :, j:j + L] * w[j]
    return out


def rglru_coeffs(u, w_a, b_a, w_x, b_x, lam):
    B, T, _ = u.shape
    f32 = jnp.float32
    uh = u.reshape(B, T, RG_HEADS, RG_HD)
    r = jax.nn.sigmoid(jnp.einsum('bthi,hij->bthj', uh, w_a.astype(f32)).reshape(B, T, RG_W) + b_a.astype(f32))
    i = jax.nn.sigmoid(jnp.einsum('bthi,hij->bthj', uh, w_x.astype(f32)).reshape(B, T, RG_W) + b_x.astype(f32))
    log_a = -RG_C * r * jax.nn.softplus(-lam.astype(f32))
    return jnp.exp(log_a), jnp.sqrt(-jnp.expm1(2.0 * log_a)) * (i * u)


def _lin_combine(left, right):
    a_l, b_l = left
    a_r, b_r = right
    return a_l * a_r, a_r * b_l + b_r


def linear_scan(a, bx, h0):
    bx = bx.at[:, 0].add(a[:, 0] * h0)
    return lax.associative_scan(_lin_combine, (a, bx), axis=1)[1]


def rglru_bidir(u, w_rg_a, b_rg_a, w_rg_x, b_rg_x, rg_lam, h0_f, h0_b):
    a_f, bx_f = rglru_coeffs(u, w_rg_a[0], b_rg_a[0], w_rg_x[0], b_rg_x[0], rg_lam[0])
    a_b, bx_b = rglru_coeffs(u, w_rg_a[1], b_rg_a[1], w_rg_x[1], b_rg_x[1], rg_lam[1])
    h_f = linear_scan(a_f, bx_f, h0_f)
    h_b_rev = linear_scan(rev(a_b), rev(bx_b), h0_b)
    return h_f, h_b_rev


def combine_groups(o_gla, z_og, g_gla, z_f, h_rg, z_rg):
    y_gla = gla_norm_gate(o_gla, z_og, g_gla)
    y_f = fourier_mix(z_f)
    y_rg = h_rg * jax.nn.gelu(z_rg.astype(jnp.float32))
    return jnp.concatenate([y_gla, y_f, y_rg], axis=-1).astype(z_og.dtype)


def context_mixer(zc, w_dec, b_dec, g_gla, w_conv, b_conv, w_rg_a, b_rg_a, w_rg_x, b_rg_x, rg_lam, with_output):
    z_q, z_k, z_v, z_dec, z_og, z_f, z_rx, z_rg = jnp.split(zc, IN_SPLITS, axis=-1)
    B = zc.shape[0]
    q, k, v, la_f, la_b = gla_prepare(z_q, z_k, z_v, z_dec, w_dec, b_dec)
    u = short_conv(z_rx.astype(jnp.float32)[:, None], w_conv, b_conv)[:, 0]
    zeros_h = jnp.zeros((B, RG_W), jnp.float32)
    h_f, h_b_rev = rglru_bidir(u, w_rg_a, b_rg_a, w_rg_x, b_rg_x, rg_lam, zeros_h, zeros_h)
    if not with_output:
        states = (gla_final_state(k, v, la_f), gla_final_state(rev(k), rev(v), rev(la_b)),
                  h_f[:, -1], h_b_rev[:, -1])
        return states, None
    s0 = jnp.zeros((B, GLA_HEADS, GLA_DK, GLA_DV), jnp.float32)
    o_f, s_f = gla_scan(q, k, v, la_f, s0)
    o_b_rev, s_b = gla_scan(rev(q), rev(k), rev(v), rev(la_b), s0)
    y = combine_groups(o_f + rev(o_b_rev), z_og, g_gla, z_f, h_f + rev(h_b_rev), z_rg)
    return (s_f, s_b, h_f[:, -1], h_b_rev[:, -1]), y


def latent_mixer(zl, states, w_dec, b_dec, g_gla, w_conv, b_conv, w_rg_a, b_rg_a, w_rg_x, b_rg_x, rg_lam):
    z_q, z_k, z_v, z_dec, z_og, z_f, z_rx, z_rg = jnp.split(zl, IN_SPLITS, axis=-1)
    B, T, _ = zl.shape
    rows = T // GRID_W
    s_f, s_b, hf0, hb0 = states
    q, k, v, la_f, la_b = gla_prepare(z_q, z_k, z_v, z_dec, w_dec, b_dec)
    o_f, _ = gla_scan(q, k, v, la_f, s_f)
    o_b_rev, _ = gla_scan(rev(q), rev(k), rev(v), rev(la_b), s_b)
    u = short_conv(z_rx.astype(jnp.float32).reshape(B, rows, GRID_W, RG_W), w_conv, b_conv).reshape(B, T, RG_W)
    h_f, h_b_rev = rglru_bidir(u, w_rg_a, b_rg_a, w_rg_x, b_rg_x, rg_lam, hf0, hb0)
    return combine_groups(o_f + rev(o_b_rev), z_og, g_gla, z_f, h_f + rev(h_b_rev), z_rg)


def setup_inputs(seed: int = 0) -> dict:
    key = jax.random.key(seed)
    ks = jax.random.split(key, 26)
    D = D_MODEL

    def nrm(k, shape, s):
        return jax.random.normal(k, shape, jnp.float32) * s

    u = jax.random.uniform(ks[19], (DEPTH, 2, RG_W), jnp.float32, 0.9, 0.999)
    p = u ** (1.0 / RG_C)
    rg_lam = jnp.log(p) - jnp.log1p(-p)
    return {
        'x': nrm(ks[0], (BATCH, SEQ, D), 1.0),
        'c': nrm(ks[1], (BATCH, D), 1.0),
        'ctx': nrm(ks[2], (BATCH, CTX_LEN, D), 1.0),
        'c_ctx': nrm(ks[3], (D,), 1.0),
        'w_ada': nrm(ks[4], (DEPTH, D, 6 * D), D ** -0.5),
        'b_ada': nrm(ks[5], (DEPTH, 6 * D), 0.01),
        'g_pre_mix': 1.0 + nrm(ks[6], (DEPTH, D), 0.05),
        'g_post_mix': 1.0 + nrm(ks[7], (DEPTH, D), 0.05),
        'g_pre_ffn': 1.0 + nrm(ks[8], (DEPTH, D), 0.05),
        'g_post_ffn': 1.0 + nrm(ks[9], (DEPTH, D), 0.05),
        'w_in': nrm(ks[10], (DEPTH, D, N_IN), D ** -0.5),
        'w_dec': nrm(ks[11], (DEPTH, 2, GLA_RANK, GLA_QK), GLA_RANK ** -0.5),
        'b_dec': nrm(ks[12], (DEPTH, 2, GLA_QK), 0.1),
        'g_gla': 1.0 + nrm(ks[13], (DEPTH, GLA_DV), 0.05),
        'w_conv': nrm(ks[14], (DEPTH, CONV_W, RG_W), CONV_W ** -0.5),
        'b_conv': nrm(ks[15], (DEPTH, RG_W), 0.01),
        'w_rg_a': nrm(ks[16], (DEPTH, 2, RG_HEADS, RG_HD, RG_HD), RG_HD ** -0.5),
        'b_rg_a': nrm(ks[17], (DEPTH, 2, RG_W), 0.01),
        'w_rg_x': nrm(ks[18], (DEPTH, 2, RG_HEADS, RG_HD, RG_HD), RG_HD ** -0.5),
        'b_rg_x': nrm(ks[20], (DEPTH, 2, RG_W), 0.01),
        'rg_lam': rg_lam,
        'w_out': nrm(ks[21], (DEPTH, MIX_W, D), MIX_W ** -0.5),
        'w_ffn_gate': nrm(ks[22], (DEPTH, D, D_FF), D ** -0.5),
        'w_ffn_up': nrm(ks[23], (DEPTH, D, D_FF), D ** -0.5),
        'w_ffn_down': nrm(ks[24], (DEPTH, D_FF, D), D_FF ** -0.5),
    }


def reference(x, c, ctx, c_ctx, w_ada, b_ada, g_pre_mix, g_post_mix, g_pre_ffn, g_post_ffn,
              w_in, w_dec, b_dec, g_gla, w_conv, b_conv, w_rg_a, b_rg_a, w_rg_x, b_rg_x,
              rg_lam, w_out, w_ffn_gate, w_ffn_up, w_ffn_down):
    silu_c = jax.nn.silu(c)
    silu_cc = jax.nn.silu(c_ctx)
    h_ctx = ctx
    for l in range(DEPTH):
        last = l == DEPTH - 1
        mod = (silu_c @ w_ada[l] + b_ada[l])[:, None, :]
        mod_c = silu_cc @ w_ada[l] + b_ada[l]
        sh1, sc1, gt1, sh2, sc2, gt2 = jnp.split(mod, 6, axis=-1)
        csh1, csc1, cgt1, csh2, csc2, cgt2 = jnp.split(mod_c, 6, axis=-1)

        hc = modulate(rmsnorm(h_ctx, g_pre_mix[l]), csh1, csc1)
        states, yc = context_mixer(hc @ w_in[l], w_dec[l], b_dec[l], g_gla[l], w_conv[l], b_conv[l],
                                   w_rg_a[l], b_rg_a[l], w_rg_x[l], b_rg_x[l], rg_lam[l],
                                   with_output=not last)
        hl = modulate(rmsnorm(x, g_pre_mix[l]), sh1, sc1)
        yl = latent_mixer(hl @ w_in[l], states, w_dec[l], b_dec[l], g_gla[l], w_conv[l], b_conv[l],
                          w_rg_a[l], b_rg_a[l], w_rg_x[l], b_rg_x[l], rg_lam[l])
        x = x + gt1 * rmsnorm(yl @ w_out[l], g_post_mix[l])

        hf = modulate(rmsnorm(x, g_pre_ffn[l]), sh2, sc2)
        x = x + gt2 * rmsnorm(swiglu(hf, w_ffn_gate[l], w_ffn_up[l], w_ffn_down[l]), g_post_ffn[l])

        if not last:
            h_ctx = h_ctx + cgt1 * rmsnorm(yc @ w_out[l], g_post_mix[l])
            hfc = modulate(rmsnorm(h_ctx, g_pre_ffn[l]), csh2, csc2)
            h_ctx = h_ctx + cgt2 * rmsnorm(swiglu(hfc, w_ffn_gate[l], w_ffn_up[l], w_ffn_down[l]), g_post_ffn[l])
    return x
```

```cpp
#include <hip/hip_runtime.h>
#include <hip/hip_cooperative_groups.h>
#include <cstdio>
#include <cstdint>
namespace cg = cooperative_groups;
namespace pg8 {
#define PG8_LAS __attribute__((address_space(3)))
typedef unsigned short bf16_t;
typedef short bf16x8 __attribute__((ext_vector_type(8)));
typedef float f32x4 __attribute__((ext_vector_type(4)));
typedef unsigned u32x4 __attribute__((ext_vector_type(4)));
constexpr int BM = 256, BK = 64, HALF = 128, HTB = HALF * BK * 2  , STAGE_BYTES = 8 * HTB, NXCD = 8, WGM = 8;

__host__ __device__ __forceinline__ int lds_byte(int r, int c) { const int st = (r >> 4) * 2 + (c >> 5), rr = r & 15, cc = c & 31, ob = rr * 64 + cc * 2; return st * 1024 + (ob ^ (((ob >> 9) & 1) << 5)); }
__host__ __device__ __forceinline__ void stage_rc(int b, int& R, int& C) { const int st = b / 1024, sb = b % 1024, swz = sb ^ (((sb >> 9) & 1) << 5); R = (st >> 1) * 16 + swz / 64; C = (st & 1) * 32 + (swz % 64) / 2; }
__host__ __device__ __forceinline__ int perm32(int rho) { const int n = rho >> 4, i = rho & 15; return 8 * (i >> 2) + 4 * n + (i & 3); }

struct Unit { int pm, pn; };
struct Gemm { const bf16_t* A; const bf16_t* Bt; int M, N, K; };

struct StaticOrder {
    int nM, nN, nwg, G, c;
    __host__ __device__ void init(int M, int N, int G_, int c_) { nM = M / BM; nN = N / BM; nwg = nM * nN; G = G_; c = c_; }
    __host__ __device__ bool next(int i, Unit& u) const {
        const long L = (long)i * G + c; if (L >= nwg) return false;
        int wgid = (int)L; { const int q = nwg / NXCD, r = nwg % NXCD, xcd = wgid % NXCD, off = wgid / NXCD; wgid = (xcd < r ? xcd * (q + 1) : r * (q + 1) + (xcd - r) * q) + off; }
        const int nig = WGM * nN, gid = wgid / nig, fm = gid * WGM, gsz = (nM - fm) < WGM ? (nM - fm) : WGM;
        u.pm = fm + ((wgid % nig) % gsz); u.pn = (wgid % nig) / gsz; return true;
    }
    __device__ __forceinline__ void a_ready(const Unit&) const {}
    __device__ __forceinline__ void done(const Unit&) const {}
};

__device__ __forceinline__ unsigned cvt_pk_bf16(float lo, float hi) { unsigned r; asm volatile("v_cvt_pk_bf16_f32 %0, %1, %2" : "=v"(r) : "v"(lo), "v"(hi)); return r; }
typedef float f32x2 __attribute__((ext_vector_type(2)));
struct EpiBf16N {
    static constexpr bool PERM = true, AFTER_DRAIN = false;
    bf16_t* O; int ldc; int nvalid;
    __device__ __forceinline__ void operator()(const f32x4 (&acc)[2][2][4][2], const Unit& u, int wr, int wc, int fr, int fq) const {
        const int row0 = u.pm * BM + wr * 64 + fr, col0 = u.pn * BM + wc * 32 + 8 * fq;
#pragma unroll
        for (int ai = 0; ai < 2; ++ai)
#pragma unroll
            for (int m = 0; m < 4; ++m) { bf16_t* rowp = O + (size_t)(row0 + ai * HALF + m * 16) * ldc;
#pragma unroll
                for (int bj = 0; bj < 2; ++bj) { const int c = col0 + bj * HALF; const f32x4 v0 = acc[ai][bj][m][0], v1 = acc[ai][bj][m][1];
                    u32x4 w; w.x = cvt_pk_bf16(v0[0], v0[1]); w.y = cvt_pk_bf16(v0[2], v0[3]); w.z = cvt_pk_bf16(v1[0], v1[1]); w.w = cvt_pk_bf16(v1[2], v1[3]);
                    if (c < nvalid) *(u32x4*)(rowp + c) = w; } }
    }
};
struct EpiF32 {
    static constexpr bool PERM = true, AFTER_DRAIN = false;
    float* O; int ldc;
    __device__ __forceinline__ void operator()(const f32x4 (&acc)[2][2][4][2], const Unit& u, int wr, int wc, int fr, int fq) const {
        const int row0 = u.pm * BM + wr * 64 + fr, col0 = u.pn * BM + wc * 32 + 8 * fq;
#pragma unroll
        for (int ai = 0; ai < 2; ++ai)
#pragma unroll
            for (int m = 0; m < 4; ++m) { float* rowp = O + (size_t)(row0 + ai * HALF + m * 16) * ldc + col0;
#pragma unroll
                for (int bj = 0; bj < 2; ++bj) { *(f32x4*)(rowp + bj * HALF) = acc[ai][bj][m][0]; *(f32x4*)(rowp + bj * HALF + 4) = acc[ai][bj][m][1]; } }
    }
};
struct EpiSwiGLU {
    static constexpr bool PERM = true, AFTER_DRAIN = false;
    bf16_t* O; int ldc;
    __device__ __forceinline__ void operator()(const f32x4 (&acc)[2][2][4][2], const Unit& u, int wr, int wc, int fr, int fq) const {
        const int row0 = u.pm * BM + wr * 64 + fr, col0 = u.pn * HALF + wc * 32 + 8 * fq;
#pragma unroll
        for (int ai = 0; ai < 2; ++ai)
#pragma unroll
            for (int m = 0; m < 4; ++m) { bf16_t* rowp = O + (size_t)(row0 + ai * HALF + m * 16) * ldc + col0;
                float h[8];
#pragma unroll
                for (int n = 0; n < 2; ++n)
#pragma unroll
                    for (int j = 0; j < 4; ++j) { const float g = acc[ai][0][m][n][j], up = acc[ai][1][m][n][j]; h[n * 4 + j] = g * __builtin_amdgcn_rcpf(1.f + __expf(-g)) * up; }
                u32x4 w; w.x = cvt_pk_bf16(h[0], h[1]); w.y = cvt_pk_bf16(h[2], h[3]); w.z = cvt_pk_bf16(h[4], h[5]); w.w = cvt_pk_bf16(h[6], h[7]);
                *(u32x4*)rowp = w; }
    }
};
template <class Epi, class Sched, bool ALIGN_EPI = false, bool SP2 = false>
__device__ __forceinline__ void gemm_phase(PG8_LAS unsigned char* lds, const Gemm g, const Sched& S, const Epi& E) {
    int tid = threadIdx.x; asm volatile("" : "+v"(tid)); const int wid = __builtin_amdgcn_readfirstlane(tid >> 6), lane = tid & 63, wr = wid >> 2, wc = wid & 3, fr = lane & 15, fq = lane >> 4;
    const int K = g.K, nt = K / BK;
    unsigned voffA[2], voffB[2];
#pragma unroll
    for (int i = 0; i < 2; ++i) { int R, C; stage_rc(tid * 16 + i * 8192, R, C); const int Rb = Epi::PERM ? ((R & ~31) + perm32(R & 31)) : R;
        voffA[i] = (unsigned)(R * K + C) * 2u; voffB[i] = (unsigned)(Rb * K + C) * 2u; }
    const size_t kstep = (size_t)(BK * 2);
    const size_t hstep = (size_t)HALF * K * 2;
    const size_t tstep = 2 * hstep;
    const unsigned ldsw = (unsigned)wid * 1024u;
    const int aoff = lds_byte(wr * 64 + fr, fq * 8), boff = lds_byte(wc * 32 + fr, fq * 8);
#define PG8_SA(b, h) (((b) * 2 + (h)) * HTB)
#define PG8_SB(b, h) ((4 + (b) * 2 + (h)) * HTB)
#define PG8_STAGE(bufoff, gbase, voff) do { _Pragma("unroll") for (int _i = 0; _i < 2; ++_i) \
        __builtin_amdgcn_global_load_lds((const unsigned*)((const char*)(gbase) + (voff)[_i]), (PG8_LAS unsigned*)(lds + (bufoff) + ldsw + _i * 8192), 16, 0, 0); } while (0)
#define PG8_LDA(dst, b, h) do { _Pragma("unroll") for (int m = 0; m < 4; ++m) _Pragma("unroll") for (int k = 0; k < 2; ++k) dst[m][k] = *(const PG8_LAS bf16x8*)(lds + PG8_SA(b, h) + aoff + m * 2048 + k * 1024); } while (0)
#define PG8_LDB(dst, b, h) do { _Pragma("unroll") for (int n = 0; n < 2; ++n) _Pragma("unroll") for (int k = 0; k < 2; ++k) dst[n][k] = *(const PG8_LAS bf16x8*)(lds + PG8_SB(b, h) + boff + n * 2048 + k * 1024); } while (0)
#define PG8_MMA(ai, bj, At, Bt) do { __builtin_amdgcn_s_setprio(1); _Pragma("unroll") for (int m = 0; m < 4; ++m) _Pragma("unroll") for (int n = 0; n < 2; ++n) _Pragma("unroll") for (int k = 0; k < 2; ++k) \
        acc[ai][bj][m][n] = __builtin_amdgcn_mfma_f32_16x16x32_bf16(Bt[n][k], At[m][k], acc[ai][bj][m][n], 0, 0, 0); __builtin_amdgcn_s_setprio(0); } while (0)
#define PG8_WAIT_V(n) asm volatile("s_waitcnt vmcnt(" #n ")" ::: "memory")
#define PG8_WAIT_L(n) asm volatile("s_waitcnt lgkmcnt(" #n ")" ::: "memory")
#define PG8_BAR __builtin_amdgcn_s_barrier()
#define PG8_SCHED __builtin_amdgcn_sched_barrier(0)
    Unit cur, nxt; int ui = 0;
    if (!S.next(0, cur)) return;
    f32x4 acc[2][2][4][2];
#pragma unroll
    for (int a = 0; a < 2; ++a)
#pragma unroll
        for (int b = 0; b < 2; ++b)
#pragma unroll
            for (int m = 0; m < 4; ++m)
#pragma unroll
                for (int n = 0; n < 2; ++n) acc[a][b][m][n] = (f32x4){0.f, 0.f, 0.f, 0.f};
    bf16x8 At[4][2], B0[2][2], B1[2][2];
    const char* cA = (const char*)g.A + (size_t)cur.pm * tstep; const char* cB = (const char*)g.Bt + (size_t)cur.pn * tstep;
    S.a_ready(cur);
    if constexpr (SP2) {
        PG8_STAGE(PG8_SB(0, 0), cB, voffB); PG8_STAGE(PG8_SB(0, 1), cB + hstep, voffB); PG8_STAGE(PG8_SA(0, 0), cA, voffA); PG8_STAGE(PG8_SA(0, 1), cA + hstep, voffA);
        if (wr == 1) PG8_BAR;
        PG8_WAIT_V(2); PG8_BAR;
        PG8_STAGE(PG8_SB(1, 0), cB + kstep, voffB); PG8_STAGE(PG8_SA(1, 0), cA + kstep, voffA); PG8_STAGE(PG8_SB(1, 1), cB + hstep + kstep, voffB);
        PG8_WAIT_V(6); PG8_BAR;
    } else {
        PG8_STAGE(PG8_SB(0, 0), cB, voffB); PG8_STAGE(PG8_SA(0, 0), cA, voffA); PG8_STAGE(PG8_SB(0, 1), cB + hstep, voffB); PG8_STAGE(PG8_SA(0, 1), cA + hstep, voffA);
        if (wr == 1) PG8_BAR;
        PG8_WAIT_V(4); PG8_BAR;
        PG8_STAGE(PG8_SB(1, 0), cB + kstep, voffB); PG8_STAGE(PG8_SA(1, 0), cA + kstep, voffA); PG8_STAGE(PG8_SB(1, 1), cB + hstep + kstep, voffB);
        PG8_WAIT_V(6); PG8_BAR;
    }
    for (;;) {
        const bool has_next = S.next(ui + 1, nxt);
        const char* nA = has_next ? (const char*)g.A + (size_t)nxt.pm * tstep : cA; const char* nB = has_next ? (const char*)g.Bt + (size_t)nxt.pn * tstep : cB;
        for (int t = 0; t < nt; t += 2) {
            const bool last = (t == nt - 2);
            const char* a1 = cA + (size_t)(t + 1) * kstep;
            const char* a2 = last ? nA : cA + (size_t)(t + 2) * kstep; const char* b2 = last ? nB : cB + (size_t)(t + 2) * kstep;
            const char* a3 = a2 + kstep; const char* b3 = b2 + kstep;
            if (last && has_next) S.a_ready(nxt);
            if constexpr (SP2) {
            PG8_LDB(B0, 0, 0); PG8_LDB(B1, 0, 1); PG8_SCHED; PG8_LDA(At, 0, 0); PG8_STAGE(PG8_SA(1, 1), a1 + hstep, voffA);
            PG8_WAIT_V(8); PG8_WAIT_L(0); PG8_BAR; PG8_MMA(0, 0, At, B0); PG8_MMA(0, 1, At, B1); PG8_BAR; PG8_SCHED;
            PG8_LDA(At, 0, 1); PG8_STAGE(PG8_SB(0, 0), b2, voffB); PG8_STAGE(PG8_SB(0, 1), b2 + hstep, voffB); PG8_STAGE(PG8_SA(0, 0), a2, voffA);
            PG8_WAIT_V(8); PG8_WAIT_L(0); PG8_BAR; PG8_MMA(1, 0, At, B0); PG8_MMA(1, 1, At, B1); PG8_BAR; PG8_SCHED;
            PG8_LDB(B0, 1, 0); PG8_LDB(B1, 1, 1); PG8_SCHED; PG8_LDA(At, 1, 0); PG8_STAGE(PG8_SA(0, 1), a2 + hstep, voffA);
            PG8_WAIT_V(8); PG8_WAIT_L(0); PG8_BAR; PG8_MMA(0, 0, At, B0); PG8_MMA(0, 1, At, B1); PG8_BAR; PG8_SCHED;
            PG8_LDA(At, 1, 1); PG8_STAGE(PG8_SB(1, 0), b3, voffB); PG8_STAGE(PG8_SB(1, 1), b3 + hstep, voffB); PG8_STAGE(PG8_SA(1, 0), a3, voffA);
            PG8_WAIT_V(8); PG8_WAIT_L(0); PG8_BAR; PG8_MMA(1, 0, At, B0); PG8_MMA(1, 1, At, B1); PG8_BAR; PG8_SCHED;
            } else {
            PG8_LDB(B0, 0, 0); PG8_SCHED; PG8_LDA(At, 0, 0); PG8_STAGE(PG8_SA(1, 1), a1 + hstep, voffA);
            PG8_WAIT_L(8); PG8_BAR; PG8_WAIT_L(0); PG8_MMA(0, 0, At, B0); PG8_BAR; PG8_SCHED;
            PG8_LDB(B1, 0, 1); PG8_STAGE(PG8_SB(0, 0), b2, voffB);
            PG8_BAR; PG8_WAIT_L(0); PG8_MMA(0, 1, At, B1); PG8_BAR;
            PG8_LDA(At, 0, 1); PG8_STAGE(PG8_SA(0, 0), a2, voffA);
            PG8_BAR; PG8_WAIT_L(0); PG8_MMA(1, 0, At, B0); PG8_BAR; PG8_SCHED;
            PG8_STAGE(PG8_SB(0, 1), b2 + hstep, voffB);
            PG8_WAIT_V(6); PG8_BAR; PG8_MMA(1, 1, At, B1); PG8_BAR;
            PG8_LDB(B0, 1, 0); PG8_SCHED; PG8_LDA(At, 1, 0); PG8_STAGE(PG8_SA(0, 1), a2 + hstep, voffA);
            PG8_WAIT_L(8); PG8_BAR; PG8_WAIT_L(0); PG8_MMA(0, 0, At, B0); PG8_BAR; PG8_SCHED;
            PG8_LDB(B1, 1, 1); PG8_STAGE(PG8_SB(1, 0), b3, voffB);
            PG8_BAR; PG8_WAIT_L(0); PG8_MMA(0, 1, At, B1); PG8_BAR;
            PG8_LDA(At, 1, 1); PG8_STAGE(PG8_SA(1, 0), a3, voffA);
            PG8_BAR; PG8_WAIT_L(0); PG8_MMA(1, 0, At, B0); PG8_BAR; PG8_SCHED;
            PG8_STAGE(PG8_SB(1, 1), b3 + hstep, voffB);
            PG8_WAIT_V(6); PG8_BAR; PG8_MMA(1, 1, At, B1); PG8_BAR;
            }
        }
        if constexpr (ALIGN_EPI) { if (wr == 0) PG8_BAR; }
        if constexpr (!Epi::AFTER_DRAIN) { E(acc, cur, wr, wc, fr, fq); S.done(cur); }
        if (!has_next) break;
#pragma unroll
        for (int a = 0; a < 2; ++a)
#pragma unroll
            for (int b = 0; b < 2; ++b)
#pragma unroll
                for (int m = 0; m < 4; ++m)
#pragma unroll
                    for (int n = 0; n < 2; ++n) acc[a][b][m][n] = (f32x4){0.f, 0.f, 0.f, 0.f};
        cur = nxt; cA = nA; cB = nB; ++ui;
        if constexpr (ALIGN_EPI) { if (wr == 1) PG8_BAR; }
    }
    PG8_WAIT_V(0);
    if constexpr (!ALIGN_EPI) { if (wr == 0) PG8_BAR; }
    PG8_BAR;
    if constexpr (Epi::AFTER_DRAIN) { E.fused(acc, cur, wr, wc, fr, fq, lds, wid, lane); S.done(cur); }
#undef PG8_SA
#undef PG8_SB
#undef PG8_STAGE
#undef PG8_LDA
#undef PG8_LDB
#undef PG8_MMA
#undef PG8_WAIT_V
#undef PG8_WAIT_L
#undef PG8_BAR
#undef PG8_SCHED
}
}
#define LAS __attribute__((address_space(3)))
typedef unsigned short bf16_t;
typedef short bf16x8 __attribute__((ext_vector_type(8)));
typedef float f32x4 __attribute__((ext_vector_type(4)));
typedef float f32x16 __attribute__((ext_vector_type(16)));
typedef unsigned u32x4 __attribute__((ext_vector_type(4)));
typedef unsigned u32x2 __attribute__((ext_vector_type(2)));

constexpr int D = 1024, NB = 8, SEQ = 4096, CTX = 256, DEPTH = 4;
constexpr int NLAT = NB * SEQ, NCTX = NB * CTX, MROWS = NLAT + NCTX;
constexpr int NIN = 2336, NINP = 2560, DFF = 2816;
constexpr int OFF_Q = 0, OFF_K = 256, OFF_V = 512, OFF_DEC = 1024, OFF_OG = 1056, OFF_F = 1568, OFF_RX = 1824, OFF_RG = 2080;
constexpr int NCHUNK = MROWS / 64;
constexpr float EPS = 1e-6f;
constexpr int NTHREADS = 512, NWAVES = 8;
constexpr int LDS_BYTES = 147456;
constexpr int TAB_OFF = LDS_BYTES - 34816;

constexpr size_t MiB = 1u << 20;
constexpr size_t WS_WIN = 0, WS_WOUT = 20 * MiB, WS_WGU = 28 * MiB, WS_WDN = 72 * MiB, WS_MOD = 94 * MiB, WS_WRG = 95 * MiB, WS_DEC = 96 * MiB,
                 WS_RGS = 98 * MiB, WS_HST = 101 * MiB, WS_XC = 103 * MiB, WS_HY = 111 * MiB, WS_A = 179 * MiB, WS_B = 366 * MiB, WS_FZ = 434 * MiB, WS_END = 502 * MiB;

struct Params { const float* in[25]; float* out; unsigned char* ws; int ph_lo, ph_hi; };
enum { I_X = 0, I_C, I_CTX, I_CCTX, I_WADA, I_BADA, I_GPREMIX, I_GPOSTMIX, I_GPREFFN, I_GPOSTFFN, I_WIN, I_WDEC, I_BDEC, I_GGLA, I_WCONV, I_BCONV,
       I_WRGA, I_BRGA, I_WRGX, I_BRGX, I_RGLAM, I_WOUT, I_WGATE, I_WUP, I_WDOWN };

__device__ __forceinline__ int tid_opaque() { int t = threadIdx.x; asm volatile("" : "+v"(t)); return t; }
__device__ __forceinline__ unsigned f2bf(float f) { unsigned u = __builtin_bit_cast(unsigned, f); return (u + 0x7fffu + ((u >> 16) & 1u)) >> 16; }
__device__ __forceinline__ unsigned pk2(float lo, float hi) { return f2bf(lo) | (f2bf(hi) << 16); }
__device__ __forceinline__ float bflo(unsigned w) { return __builtin_bit_cast(float, w << 16); }
__device__ __forceinline__ float bfhi(unsigned w) { return __builtin_bit_cast(float, w & 0xffff0000u); }
__device__ __forceinline__ float bf1(unsigned short h) { return __builtin_bit_cast(float, (unsigned)h << 16); }
#define BFE(v, i) (((i) & 1) ? bfhi((v)[(i) >> 1]) : bflo((v)[(i) >> 1]))
__device__ __forceinline__ float wave_sum(float v) {
#pragma unroll
    for (int o = 1; o < 64; o <<= 1) v += __shfl_xor(v, o);
    return v;
}
__device__ __forceinline__ float sigmoidf_(float x) { return 1.f / (1.f + __expf(-x)); }
__device__ __forceinline__ bf16x8 ldv(const LAS bf16_t* p) { return *(const LAS bf16x8*)p; }
__device__ __forceinline__ bf16x8 ldv(const bf16_t* p) { return *(const bf16x8*)p; }
template <class PA, class PB> __device__ __forceinline__ void mma64(f32x16& acc, PA a, PB b) {
#pragma unroll
    for (int k0 = 0; k0 < 64; k0 += 16) acc = __builtin_amdgcn_mfma_f32_32x32x16_bf16(ldv(a + k0), ldv(b + k0), acc, 0, 0, 0);
}
#define ACC_ROW(reg, hi) (((reg) & 3) + 8 * ((reg) >> 2) + 4 * (hi))
#define ZERO16 ((f32x16){0.f,0.f,0.f,0.f,0.f,0.f,0.f,0.f,0.f,0.f,0.f,0.f,0.f,0.f,0.f,0.f})

__device__ __forceinline__ void transpose_item(const float* W, int N, bf16_t* WT, int ldk, int k0, int n0, int drow0, LAS float* scr, int lane) {
#pragma unroll 8
    for (int i = 0; i < 32; ++i) { const int kk = 2 * i + (lane >> 5); scr[kk * 33 + (lane & 31)] = W[(size_t)(k0 + kk) * N + n0 + (lane & 31)]; }
    asm volatile("s_waitcnt lgkmcnt(0)" ::: "memory");
    const int c = lane & 7;
#pragma unroll
    for (int j = 0; j < 4; ++j) { const int n = (lane >> 3) + 8 * j; const LAS float* s = scr + (8 * c) * 33 + n;
        u32x4 o; o.x = pk2(s[0 * 33], s[1 * 33]); o.y = pk2(s[2 * 33], s[3 * 33]); o.z = pk2(s[4 * 33], s[5 * 33]); o.w = pk2(s[6 * 33], s[7 * 33]);
        *(u32x4*)(WT + (size_t)(drow0 + n) * ldk + k0 + 8 * c) = o; }
    asm volatile("s_waitcnt lgkmcnt(0)" ::: "memory");
}

__device__ __forceinline__ void phase_prologue(const Params& p, LAS unsigned char* L) {
    const int tid = tid_opaque(), lane = tid & 63, wave = tid >> 6;
    unsigned char* ws = p.ws;
    {
        LAS float* scr = (LAS float*)(L + wave * 16384);
        const int gw = blockIdx.x * NWAVES + wave, NGW = gridDim.x * NWAVES;
        constexpr int I_IN = 16 * 73, I_OUT = 16 * 32, I_G = 16 * 88, I_DN = 44 * 32, I_L = I_IN + I_OUT + 2 * I_G + I_DN;
        for (int it = gw; it < DEPTH * I_L; it += NGW) {
            const int l = it / I_L; int r = it % I_L;
            if (r < I_IN) { const int kb = r / 73, nb = r % 73; transpose_item(p.in[I_WIN] + (size_t)l * D * NIN, NIN, (bf16_t*)(ws + WS_WIN) + (size_t)l * NINP * D, D, kb * 64, nb * 32, nb * 32, scr, lane); continue; }
            r -= I_IN;
            if (r < I_OUT) { const int kb = r / 32, nb = r % 32; transpose_item(p.in[I_WOUT] + (size_t)l * D * D, D, (bf16_t*)(ws + WS_WOUT) + (size_t)l * D * D, D, kb * 64, nb * 32, nb * 32, scr, lane); continue; }
            r -= I_OUT;
            if (r < 2 * I_G) { const int up = r >= I_G; if (up) r -= I_G; const int kb = r / 88, nb = r % 88, n0 = nb * 32;
                transpose_item(p.in[up ? I_WUP : I_WGATE] + (size_t)l * D * DFF, DFF, (bf16_t*)(ws + WS_WGU) + (size_t)l * 2 * DFF * D, D, kb * 64, n0, 256 * (n0 >> 7) + (n0 & 127) + (up ? 128 : 0), scr, lane); continue; }
            r -= 2 * I_G;
            { const int kb = r / 32, nb = r % 32; transpose_item(p.in[I_WDOWN] + (size_t)l * DFF * D, D, (bf16_t*)(ws + WS_WDN) + (size_t)l * D * DFF, DFF, kb * 64, nb * 32, nb * 32, scr, lane); }
        }
        const int gt = blockIdx.x * NTHREADS + tid, NGT = gridDim.x * NTHREADS;
        constexpr int PADV = (NINP - NIN) * D / 8;
        for (int i = gt; i < DEPTH * PADV; i += NGT) { const int l = i / PADV, q = i % PADV;
            *(u32x4*)((bf16_t*)(ws + WS_WIN) + (size_t)l * NINP * D + (size_t)NIN * D + (size_t)q * 8) = (u32x4){0u, 0u, 0u, 0u}; }
        for (int i = gt; i < DEPTH * 2 * 2 * 4 * 4096; i += NGT) {
            const int in_ = i & 63, out_ = (i >> 6) & 63, head = (i >> 12) & 3, ax = (i >> 14) & 1, dir = (i >> 15) & 1, l = i >> 16;
            const float* W = p.in[ax ? I_WRGX : I_WRGA];
            ((bf16_t*)(ws + WS_WRG))[i] = (bf16_t)f2bf(W[((((size_t)l * 2 + dir) * 4 + head) * 64 + in_) * 64 + out_]);
        }
    }
    __syncthreads();
    {
        LAS float* sl = (LAS float*)L;
        LAS float* red = (LAS float*)(L + 36864);
        for (int i = tid; i < 9 * 1024; i += NTHREADS) { const int r = i >> 10, k = i & 1023; const float v = (r < 8) ? p.in[I_C][r * 1024 + k] : p.in[I_CCTX][k]; sl[i] = v / (1.f + __expf(-v)); }
        __syncthreads();
        float* MOD = (float*)(ws + WS_MOD);
        for (int item = blockIdx.x; item < DEPTH * 96; item += gridDim.x) {
            const int l = item / 96, cb = item % 96, cc = tid & 63, kg = tid >> 6;
            const float* w = p.in[I_WADA] + ((size_t)l * 1024 + kg * 128) * 6144 + cb * 64 + cc;
            float a0 = 0.f, a1 = 0.f, a2 = 0.f, a3 = 0.f, a4 = 0.f, a5 = 0.f, a6 = 0.f, a7 = 0.f, a8 = 0.f;
            const LAS float* s = sl + kg * 128;
#pragma unroll 8
            for (int k = 0; k < 128; ++k) { const float wv = w[(size_t)k * 6144];
                a0 += s[k] * wv; a1 += s[1024 + k] * wv; a2 += s[2048 + k] * wv; a3 += s[3072 + k] * wv; a4 += s[4096 + k] * wv;
                a5 += s[5120 + k] * wv; a6 += s[6144 + k] * wv; a7 += s[7168 + k] * wv; a8 += s[8192 + k] * wv; }
            LAS float* rp = red + kg * 576 + cc;
            rp[0] = a0; rp[64] = a1; rp[128] = a2; rp[192] = a3; rp[256] = a4; rp[320] = a5; rp[384] = a6; rp[448] = a7; rp[512] = a8;
            __syncthreads();
            for (int i = tid; i < 576; i += NTHREADS) { float sum = 0.f;
#pragma unroll
                for (int g = 0; g < 8; ++g) sum += red[g * 576 + i];
                const int r = i >> 6, c2 = i & 63; MOD[((size_t)l * 9 + r) * 6144 + cb * 64 + c2] = sum + p.in[I_BADA][l * 6144 + cb * 64 + c2]; }
            __syncthreads();
        }
    }
}

__device__ __forceinline__ void rows_phase(const Params& p, const bool HAS_T, int nrows, const float* xlat_src, const float* xctx_src, const float* T, const float* gpost, const float* modT, int gt_off,
                                           bool want_h, const float* gpre, const float* modH, int sh_off, int sc_off) {
    const int tid = tid_opaque(), lane = tid & 63, wave = tid >> 6;
    const int gw = blockIdx.x * NWAVES + wave, NGW = gridDim.x * NWAVES;
    float* xlat_dst = p.out; float* xctx_dst = (float*)(p.ws + WS_XC); bf16_t* H = (bf16_t*)(p.ws + WS_HY);
    for (int row = gw; row < nrows; row += NGW) {
        const bool isctx = row >= NLAT; const int mrow = isctx ? 8 : (row >> 12);
        const float* xs = isctx ? xctx_src + (size_t)(row - NLAT) * D : xlat_src + (size_t)row * D;
        f32x4 x[4];
#pragma unroll
        for (int j = 0; j < 4; ++j) x[j] = *(const f32x4*)(xs + 4 * lane + 256 * j);
        if (HAS_T) {
            f32x4 t[4]; float ss = 0.f;
#pragma unroll
            for (int j = 0; j < 4; ++j) { t[j] = *(const f32x4*)(T + (size_t)row * D + 4 * lane + 256 * j); ss += t[j].x * t[j].x + t[j].y * t[j].y + t[j].z * t[j].z + t[j].w * t[j].w; }
            const float rstd = rsqrtf(wave_sum(ss) * (1.f / D) + EPS);
            const float* mt = modT + (size_t)mrow * 6144 + gt_off;
            float* xd = isctx ? xctx_dst + (size_t)(row - NLAT) * D : xlat_dst + (size_t)row * D;
#pragma unroll
            for (int j = 0; j < 4; ++j) { const f32x4 g = *(const f32x4*)(gpost + 4 * lane + 256 * j), gt = *(const f32x4*)(mt + 4 * lane + 256 * j);
                x[j] = x[j] + gt * (t[j] * rstd * g); *(f32x4*)(xd + 4 * lane + 256 * j) = x[j]; }
        }
        if (want_h) {
            float ss = 0.f;
#pragma unroll
            for (int j = 0; j < 4; ++j) ss += x[j].x * x[j].x + x[j].y * x[j].y + x[j].z * x[j].z + x[j].w * x[j].w;
            const float rstd = rsqrtf(wave_sum(ss) * (1.f / D) + EPS);
            const float* mh = modH + (size_t)mrow * 6144;
#pragma unroll
            for (int j = 0; j < 4; ++j) { const f32x4 g = *(const f32x4*)(gpre + 4 * lane + 256 * j), sh = *(const f32x4*)(mh + sh_off + 4 * lane + 256 * j), sc = *(const f32x4*)(mh + sc_off + 4 * lane + 256 * j);
                const f32x4 h = (x[j] * rstd * g) * (sc + 1.f) + sh;
                u32x2 o; o.x = pk2(h.x, h.y); o.y = pk2(h.z, h.w); *(u32x2*)(H + (size_t)row * D + 4 * lane + 256 * j) = o; }
        }
    }
}

__device__ __forceinline__ int scan_cid(int b, int dir, int s) { return (s < 4) ? (512 + b * 4 + (dir ? 3 - s : s)) : (b * 64 + (dir ? 63 - (s - 4) : (s - 4))); }

constexpr int G_LR = 0, G_SEG = 8192, G_CUM = 10240, G_TOT = 43008, G_T0 = 43520;
__device__ __forceinline__ void gla_decays(const Params& p, LAS unsigned char* L, int l, int cid, int h) {
    const int tid = tid_opaque();
    const bf16_t* Z = (const bf16_t*)(p.ws + WS_A);
    LAS float* LR = (LAS float*)(L + G_LR); LAS float* SEG = (LAS float*)(L + G_SEG); LAS float* CUM = (LAS float*)(L + G_CUM); LAS float* TOT = (LAS float*)(L + G_TOT);
    const int r0 = cid * 64;
    if (tid < 256) { const int t = tid >> 2, q = tid & 3; const u32x4 v = *(const u32x4*)(Z + (size_t)(r0 + t) * NIN + OFF_DEC + q * 8);
#pragma unroll
        for (int i = 0; i < 8; ++i) LR[t * 32 + q * 8 + i] = BFE(v, i); }
    __syncthreads();
    const int d = tid >> 8, k = tid & 63, tq = (tid >> 6) & 3;
    float w[16];
#pragma unroll
    for (int r = 0; r < 16; ++r) w[r] = p.in[I_WDEC][(((size_t)l * 2 + d) * 16 + r) * 256 + h * 64 + k];
    const float bias = p.in[I_BDEC][((size_t)l * 2 + d) * 256 + h * 64 + k];
    float la[16];
#pragma unroll
    for (int i = 0; i < 16; ++i) { const LAS float* lr = LR + (tq * 16 + i) * 32 + d * 16; float logit = bias;
#pragma unroll
        for (int r = 0; r < 16; ++r) logit += lr[r] * w[r];
        la[i] = (fminf(logit, 0.f) - log1pf(__expf(-fabsf(logit)))) * (1.f / 16.f); }
    if (d == 0) {
#pragma unroll
        for (int i = 1; i < 16; ++i) la[i] += la[i - 1];
        SEG[(0 * 4 + tq) * 64 + k] = la[15];
    } else {
#pragma unroll
        for (int i = 14; i >= 0; --i) la[i] += la[i + 1];
        SEG[(1 * 4 + tq) * 64 + k] = la[0];
    }
    __syncthreads();
    float off = 0.f, tot = 0.f;
#pragma unroll
    for (int q = 0; q < 4; ++q) { const float sv = SEG[(d * 4 + q) * 64 + k]; tot += sv; if (d == 0 ? (q < tq) : (q > tq)) off += sv; }
#pragma unroll
    for (int i = 0; i < 16; ++i) CUM[(d * 64 + tq * 16 + i) * 64 + k] = la[i] + off;
    if (tq == 0) TOT[d * 64 + k] = tot;
    __syncthreads();
}

__device__ __forceinline__ void gla_vt(const bf16_t* Z, LAS bf16_t* VT, int r0, int h) {
    const int tid = tid_opaque(), t = tid >> 3, vq = tid & 7;
#pragma unroll
    for (int half = 0; half < 2; ++half) { const u32x4 v = *(const u32x4*)(Z + (size_t)(r0 + t) * NIN + OFF_V + h * 128 + vq * 16 + half * 8);
#pragma unroll
        for (int i = 0; i < 8; ++i) VT[(vq * 16 + half * 8 + i) * 72 + t] = (bf16_t)((i & 1) ? (v[i >> 1] >> 16) : (v[i >> 1] & 0xffffu)); }
}

__device__ __forceinline__ void gla_g1(const Params& p, LAS unsigned char* L, int l, int cid, int h) {
    const int tid = tid_opaque(), lane = tid & 63, wave = tid >> 6, r = lane & 31, hi = lane >> 5;
    const bf16_t* Z = (const bf16_t*)(p.ws + WS_A);
    gla_decays(p, L, l, cid, h);
    LAS float* CUM = (LAS float*)(L + G_CUM); LAS float* TOT = (LAS float*)(L + G_TOT);
    LAS bf16_t* KEF = (LAS bf16_t*)(L + G_T0); LAS bf16_t* KEB = (LAS bf16_t*)(L + G_T0 + 9216); LAS bf16_t* VT = (LAS bf16_t*)(L + G_T0 + 18432);
    const int r0 = cid * 64;
    { const int t = tid >> 3, kq = tid & 7; const u32x4 kv = *(const u32x4*)(Z + (size_t)(r0 + t) * NIN + OFF_K + h * 64 + kq * 8);
#pragma unroll
      for (int i = 0; i < 8; ++i) { const int k = kq * 8 + i; const float kval = BFE(kv, i);
          KEF[k * 72 + t] = (bf16_t)f2bf(kval * __expf(TOT[k] - CUM[t * 64 + k]));
          KEB[k * 72 + t] = (bf16_t)f2bf(kval * __expf(TOT[64 + k] - CUM[(64 + t) * 64 + k])); } }
    gla_vt(Z, VT, r0, h);
    __syncthreads();
    const int dvb = wave & 3, dkb = wave >> 2;
    f32x16 accf = ZERO16, accb = ZERO16;
    const LAS bf16_t* aF = KEF + (dkb * 32 + r) * 72 + 8 * hi; const LAS bf16_t* aB = KEB + (dkb * 32 + r) * 72 + 8 * hi; const LAS bf16_t* bV = VT + (dvb * 32 + r) * 72 + 8 * hi;
    mma64(accf, aF, bV); mma64(accb, aB, bV);
    bf16_t* US = (bf16_t*)(p.ws + WS_B);
    bf16_t* uf = US + ((size_t)((cid * 4 + h) * 2 + 0) * 128 + dvb * 32 + r) * 64 + dkb * 32 + 4 * hi;
    bf16_t* ub = US + ((size_t)((cid * 4 + h) * 2 + 1) * 128 + dvb * 32 + r) * 64 + dkb * 32 + 4 * hi;
#pragma unroll
    for (int g = 0; g < 4; ++g) { u32x2 o; o.x = pk2(accf[4 * g], accf[4 * g + 1]); o.y = pk2(accf[4 * g + 2], accf[4 * g + 3]); *(u32x2*)(uf + 8 * g) = o;
        o.x = pk2(accb[4 * g], accb[4 * g + 1]); o.y = pk2(accb[4 * g + 2], accb[4 * g + 3]); *(u32x2*)(ub + 8 * g) = o; }
    if (tid < 128) ((float*)(p.ws + WS_DEC))[(size_t)((cid * 4 + h) * 2 + (tid >> 6)) * 64 + (tid & 63)] = __expf(TOT[tid]);
    __syncthreads();
}

__device__ __forceinline__ void gla_g2(const Params& p, int item) {
    const int gid = item * NTHREADS + tid_opaque(), dk4 = gid & 15, dv = (gid >> 4) & 127, seq = gid >> 11, dir = seq & 1, h = (seq >> 1) & 3, b = seq >> 3;
    bf16_t* US = (bf16_t*)(p.ws + WS_B); const float* DEC = (const float*)(p.ws + WS_DEC);
    float s0 = 0.f, s1 = 0.f, s2 = 0.f, s3 = 0.f;
#pragma unroll 4
    for (int s = 0; s < 68; ++s) {
        const int cid = scan_cid(b, dir, s); const size_t tile = (size_t)((cid * 4 + h) * 2 + dir);
        u32x2* up = (u32x2*)(US + (tile * 128 + dv) * 64 + dk4 * 4);
        const u32x2 u = *up; const f32x4 d = *(const f32x4*)(DEC + tile * 64 + dk4 * 4);
        u32x2 o; o.x = pk2(s0, s1); o.y = pk2(s2, s3); *up = o;
        s0 = s0 * d.x + bflo(u.x); s1 = s1 * d.y + bfhi(u.x); s2 = s2 * d.z + bflo(u.y); s3 = s3 * d.w + bfhi(u.y);
    }
}

__device__ __forceinline__ void gla_g3(const Params& p, LAS unsigned char* L, int l, int cid, int h) {
    const int tid = tid_opaque(), lane = tid & 63, wave = tid >> 6, r = lane & 31, hi = lane >> 5;
    const bf16_t* Z = (const bf16_t*)(p.ws + WS_A);
    gla_decays(p, L, l, cid, h);
    LAS float* CUM = (LAS float*)(L + G_CUM);
    LAS bf16_t* QF = (LAS bf16_t*)(L + G_T0); LAS bf16_t* KF = (LAS bf16_t*)(L + G_T0 + 9216); LAS bf16_t* QB = (LAS bf16_t*)(L + G_T0 + 18432); LAS bf16_t* KB = (LAS bf16_t*)(L + G_T0 + 27648);
    LAS bf16_t* VT = (LAS bf16_t*)(L + G_T0 + 36864); LAS bf16_t* AF = (LAS bf16_t*)(L + G_T0 + 55296); LAS bf16_t* AB = (LAS bf16_t*)(L + G_T0 + 64512);
    LAS float* OST = (LAS float*)L;
    const int r0 = cid * 64;
    { const int t = tid >> 3, kq = tid & 7;
      const u32x4 qv = *(const u32x4*)(Z + (size_t)(r0 + t) * NIN + OFF_Q + h * 64 + kq * 8), kv = *(const u32x4*)(Z + (size_t)(r0 + t) * NIN + OFF_K + h * 64 + kq * 8);
      float qf[8], kf[8], qb[8], kb[8];
#pragma unroll
      for (int i = 0; i < 8; ++i) { const int k = kq * 8 + i; const float q = BFE(qv, i) * 0.125f, kk = BFE(kv, i), bw = CUM[t * 64 + k], cw = CUM[(64 + t) * 64 + k];
          qf[i] = q * __expf(bw); kf[i] = kk * __expf(-bw); qb[i] = q * __expf(cw); kb[i] = kk * __expf(-cw); }
      u32x4 o;
      o.x = pk2(qf[0], qf[1]); o.y = pk2(qf[2], qf[3]); o.z = pk2(qf[4], qf[5]); o.w = pk2(qf[6], qf[7]); *(LAS u32x4*)(QF + t * 72 + kq * 8) = o;
      o.x = pk2(kf[0], kf[1]); o.y = pk2(kf[2], kf[3]); o.z = pk2(kf[4], kf[5]); o.w = pk2(kf[6], kf[7]); *(LAS u32x4*)(KF + t * 72 + kq * 8) = o;
      o.x = pk2(qb[0], qb[1]); o.y = pk2(qb[2], qb[3]); o.z = pk2(qb[4], qb[5]); o.w = pk2(qb[6], qb[7]); *(LAS u32x4*)(QB + t * 72 + kq * 8) = o;
      o.x = pk2(kb[0], kb[1]); o.y = pk2(kb[2], kb[3]); o.z = pk2(kb[4], kb[5]); o.w = pk2(kb[6], kb[7]); *(LAS u32x4*)(KB + t * 72 + kq * 8) = o; }
    gla_vt(Z, VT, r0, h);
    __syncthreads();
    {
      const int bw = wave >> 2, ib = wave & 1, jb = (wave >> 1) & 1;
      f32x16 acc = ZERO16;
      const bool live = bw ? (jb >= ib) : (jb <= ib);
      if (live) { if (bw) mma64(acc, QB + (ib * 32 + r) * 72 + 8 * hi, KB + (jb * 32 + r) * 72 + 8 * hi); else mma64(acc, QF + (ib * 32 + r) * 72 + 8 * hi, KF + (jb * 32 + r) * 72 + 8 * hi); }
      LAS bf16_t* AT = bw ? AB : AF; const int j = jb * 32 + r;
#pragma unroll
      for (int reg = 0; reg < 16; ++reg) { const int i = ib * 32 + ACC_ROW(reg, hi); const bool keep = bw ? (j >= i) : (j <= i); AT[i * 72 + j] = (bf16_t)f2bf(keep ? acc[reg] : 0.f); } }
    __syncthreads();
    const int tb = wave & 1, dvb = wave >> 1;
    f32x16 acc = ZERO16;
    { const LAS bf16_t* bV = VT + (dvb * 32 + r) * 72 + 8 * hi;
      mma64(acc, AF + (tb * 32 + r) * 72 + 8 * hi, bV); mma64(acc, AB + (tb * 32 + r) * 72 + 8 * hi, bV);
      const bf16_t* US = (const bf16_t*)(p.ws + WS_B);
      const bf16_t* sF = US + ((size_t)((cid * 4 + h) * 2 + 0) * 128 + dvb * 32 + r) * 64 + 8 * hi; const bf16_t* sB = US + ((size_t)((cid * 4 + h) * 2 + 1) * 128 + dvb * 32 + r) * 64 + 8 * hi;
      mma64(acc, QF + (tb * 32 + r) * 72 + 8 * hi, sF); mma64(acc, QB + (tb * 32 + r) * 72 + 8 * hi, sB); }
#pragma unroll
    for (int reg = 0; reg < 16; ++reg) OST[(tb * 32 + ACC_ROW(reg, hi)) * 132 + dvb * 32 + r] = acc[reg];
    __syncthreads();
    { const int t = tid >> 3, part = tid & 7; float o[16]; float ss = 0.f;
#pragma unroll
      for (int i = 0; i < 16; ++i) { o[i] = OST[t * 132 + part * 16 + i]; ss += o[i] * o[i]; }
      ss += __shfl_xor(ss, 1); ss += __shfl_xor(ss, 2); ss += __shfl_xor(ss, 4);
      const float rstd = rsqrtf(ss * (1.f / 128.f) + EPS);
      const float* gg = p.in[I_GGLA] + l * 128 + part * 16;
      bf16_t* Y = (bf16_t*)(p.ws + WS_HY) + (size_t)(r0 + t) * D + h * 128 + part * 16;
#pragma unroll
      for (int half = 0; half < 2; ++half) { const u32x4 og = *(const u32x4*)(Z + (size_t)(r0 + t) * NIN + OFF_OG + h * 128 + part * 16 + half * 8); float y[8];
#pragma unroll
          for (int i = 0; i < 8; ++i) { const float z = BFE(og, i); y[i] = o[half * 8 + i] * rstd * gg[half * 8 + i] * (z / (1.f + __expf(-z))); }
          u32x4 w; w.x = pk2(y[0], y[1]); w.y = pk2(y[2], y[3]); w.z = pk2(y[4], y[5]); w.w = pk2(y[6], y[7]); *(u32x4*)(Y + half * 8) = w; } }
    __syncthreads();
}

constexpr int R_UB = 0, R_UF = 9216, R_AA = 25600, R_BX = 58368;
template <bool FINAL>
__device__ __forceinline__ void rg_item(const Params& p, LAS unsigned char* L, int l, int cid, int head) {
    const int tid = tid_opaque(), lane = tid & 63, wave = tid >> 6, r = lane & 31, hi = lane >> 5;
    const bf16_t* Z = (const bf16_t*)(p.ws + WS_A);
    LAS bf16_t* UB = (LAS bf16_t*)(L + R_UB); LAS float* UF = (LAS float*)(L + R_UF); LAS float* AA = (LAS float*)(L + R_AA); LAS float* BX = (LAS float*)(L + R_BX);
    const int r0 = cid * 64;
    { const int t = tid >> 3, cq = tid & 7, ch0 = head * 64 + cq * 8;
      int pos, len, lbase;
      if (cid < 512) { pos = t; len = 64; lbase = r0; } else { const int n = (cid - 512) & 3; pos = n * 64 + t; len = 256; lbase = r0 - n * 64; }
      float u[8];
#pragma unroll
      for (int i = 0; i < 8; ++i) u[i] = p.in[I_BCONV][l * 256 + ch0 + i];
#pragma unroll
      for (int j = 0; j < 4; ++j) { const int pp = pos + j - 1;
          if (pp >= 0 && pp < len) { const u32x4 zv = *(const u32x4*)(Z + (size_t)(lbase + pp) * NIN + OFF_RX + ch0); const float* wc = p.in[I_WCONV] + ((size_t)l * 4 + j) * 256 + ch0;
#pragma unroll
              for (int i = 0; i < 8; ++i) u[i] += wc[i] * BFE(zv, i); } }
      u32x4 o; o.x = pk2(u[0], u[1]); o.y = pk2(u[2], u[3]); o.z = pk2(u[4], u[5]); o.w = pk2(u[6], u[7]); *(LAS u32x4*)(UB + t * 72 + cq * 8) = o;
      *(LAS f32x4*)(UF + t * 64 + cq * 8) = (f32x4){u[0], u[1], u[2], u[3]}; *(LAS f32x4*)(UF + t * 64 + cq * 8 + 4) = (f32x4){u[4], u[5], u[6], u[7]}; }
    __syncthreads();
    { const int tb = wave & 1, ob = (wave >> 1) & 1, dir = wave >> 2;
      const bf16_t* WRG = (const bf16_t*)(p.ws + WS_WRG);
      const bf16_t* bA = WRG + ((((size_t)(l * 2 + dir) * 2 + 0) * 4 + head) * 64 + ob * 32 + r) * 64 + 8 * hi;
      const bf16_t* bXw = WRG + ((((size_t)(l * 2 + dir) * 2 + 1) * 4 + head) * 64 + ob * 32 + r) * 64 + 8 * hi;
      const LAS bf16_t* aU = UB + (tb * 32 + r) * 72 + 8 * hi;
      f32x16 accA = ZERO16, accX = ZERO16; mma64(accA, aU, bA); mma64(accX, aU, bXw);
      const int ch = ob * 32 + r, gch = head * 64 + ch;
      const float ba = p.in[I_BRGA][(l * 2 + dir) * 256 + gch], bx_ = p.in[I_BRGX][(l * 2 + dir) * 256 + gch], lam = p.in[I_RGLAM][(l * 2 + dir) * 256 + gch];
      const float sp = fmaxf(-lam, 0.f) + log1pf(__expf(-fabsf(lam)));
#pragma unroll
      for (int reg = 0; reg < 16; ++reg) { const int tt = tb * 32 + ACC_ROW(reg, hi);
          const float rr = sigmoidf_(accA[reg] + ba), ii = sigmoidf_(accX[reg] + bx_), loga = -8.f * rr * sp, a = __expf(loga), mult = sqrtf(-expm1f(2.f * loga));
          AA[(dir * 64 + tt) * 64 + ch] = a; BX[(dir * 64 + tt) * 64 + ch] = mult * ii * UF[tt * 64 + ch]; } }
    __syncthreads();
    if (tid < 128) { const int dir = tid >> 6, ch = tid & 63;
        if (!FINAL) { float hh = 0.f, P = 1.f;
#pragma unroll 4
            for (int s = 0; s < 64; ++s) { const int t = dir ? 63 - s : s; const float a = AA[(dir * 64 + t) * 64 + ch]; hh = a * hh + BX[(dir * 64 + t) * 64 + ch]; P *= a; }
            float* RGS = (float*)(p.ws + WS_RGS) + (size_t)(((cid * 4 + head) * 2 + dir) * 2) * 64 + ch; RGS[0] = P; RGS[64] = hh;
        } else { float hh = ((const float*)(p.ws + WS_HST))[(size_t)(cid * 2 + dir) * 256 + head * 64 + ch];
#pragma unroll 4
            for (int s = 0; s < 64; ++s) { const int t = dir ? 63 - s : s; hh = AA[(dir * 64 + t) * 64 + ch] * hh + BX[(dir * 64 + t) * 64 + ch]; BX[(dir * 64 + t) * 64 + ch] = hh; } } }
    __syncthreads();
    if (FINAL) { const int t = tid >> 3, cq = tid & 7;
        const u32x4 zg = *(const u32x4*)(Z + (size_t)(r0 + t) * NIN + OFF_RG + head * 64 + cq * 8); float y[8];
#pragma unroll
        for (int i = 0; i < 8; ++i) { const float hs = BX[t * 64 + cq * 8 + i] + BX[(64 + t) * 64 + cq * 8 + i], z = BFE(zg, i);
            const float ge = 0.5f * z * (1.f + tanhf(0.7978845608028654f * (z + 0.044715f * z * z * z))); y[i] = hs * ge; }
        u32x4 w; w.x = pk2(y[0], y[1]); w.y = pk2(y[2], y[3]); w.z = pk2(y[4], y[5]); w.w = pk2(y[6], y[7]);
        *(u32x4*)((bf16_t*)(p.ws + WS_HY) + (size_t)(r0 + t) * D + 768 + head * 64 + cq * 8) = w;
        __syncthreads(); }
}
__device__ __forceinline__ void rg_r2(const Params& p, int item) {
    const int gid = item * NTHREADS + tid_opaque(), ch = gid & 255, dir = (gid >> 8) & 1, b = gid >> 9, head = ch >> 6, c = ch & 63;
    const float* RGS = (const float*)(p.ws + WS_RGS); float* HST = (float*)(p.ws + WS_HST);
    float hh = 0.f;
#pragma unroll 4
    for (int s = 0; s < 68; ++s) { const int cid = scan_cid(b, dir, s); const float* q = RGS + (size_t)(((cid * 4 + head) * 2 + dir) * 2) * 64 + c;
        HST[(size_t)(cid * 2 + dir) * 256 + ch] = hh; hh = q[0] * hh + q[64]; }
}

__device__ __forceinline__ void fourier_tables(LAS unsigned char* L) {
    LAS bf16_t* CM = (LAS bf16_t*)(L + TAB_OFF); LAS bf16_t* SM = (LAS bf16_t*)(L + TAB_OFF + 9216); LAS float* COST = (LAS float*)(L + TAB_OFF + 18432);
    for (int i = tid_opaque(); i < 4096; i += NTHREADS) { COST[i] = cospif((float)i * (1.f / 2048.f)); const int rr = i >> 6, c = i & 63; const float a = (float)((rr * c) & 63) * (1.f / 32.f);
        CM[rr * 72 + c] = (bf16_t)f2bf(cospif(a)); SM[rr * 72 + c] = (bf16_t)f2bf(sinpif(a)); }
    __syncthreads();
}
__device__ __forceinline__ void fourier_f1(const Params& p, LAS unsigned char* L, int b, int g, int tab) {
    const int tid = tid_opaque(), lane = tid & 63, wave = tid >> 6, r = lane & 31, hi = lane >> 5;
    const bf16_t* Z = (const bf16_t*)(p.ws + WS_A); bf16_t* FZ = (bf16_t*)(p.ws + WS_FZ);
    const LAS bf16_t* CM = (const LAS bf16_t*)(L + TAB_OFF); const LAS bf16_t* SM = (const LAS bf16_t*)(L + TAB_OFF + 9216); const LAS float* COST = (const LAS float*)(L + TAB_OFF + 18432);
    const int set = wave >> 2, wl = wave & 3;
    LAS bf16_t* X = (LAS bf16_t*)(L + set * 27648); LAS bf16_t* AT = X + 4608; LAS bf16_t* BT = X + 9216;
    for (int it = 0; it < 4; ++it) {
#pragma unroll
        for (int s = 0; s < 2; ++s) { const int ta = tab * 8 + it * 2 + s, tb = tid >> 3, cq = tid & 7;
            *(LAS u32x4*)((LAS bf16_t*)(L + s * 27648) + tb * 72 + cq * 8) = *(const u32x4*)(Z + (size_t)(b * 4096 + 64 * tb + ta) * NIN + OFF_F + g * 64 + cq * 8); }
        __syncthreads();
        { const int tbb = wl & 1, mb = wl >> 1; f32x16 aC = ZERO16, aS = ZERO16;
          const LAS bf16_t* aX = X + (tbb * 32 + r) * 72 + 8 * hi;
          mma64(aC, aX, CM + (mb * 32 + r) * 72 + 8 * hi); mma64(aS, aX, SM + (mb * 32 + r) * 72 + 8 * hi);
          const int m = mb * 32 + r;
#pragma unroll
          for (int q = 0; q < 4; ++q) { u32x2 o; o.x = pk2(aC[4 * q], aC[4 * q + 1]); o.y = pk2(aC[4 * q + 2], aC[4 * q + 3]); *(LAS u32x2*)(AT + m * 72 + tbb * 32 + 8 * q + 4 * hi) = o;
              o.x = pk2(-aS[4 * q], -aS[4 * q + 1]); o.y = pk2(-aS[4 * q + 2], -aS[4 * q + 3]); *(LAS u32x2*)(BT + m * 72 + tbb * 32 + 8 * q + 4 * hi) = o; } }
        __syncthreads();
        { const int kab = wl & 1, mb = wl >> 1; f32x16 zr = ZERO16, z1 = ZERO16, z2 = ZERO16;
          const LAS bf16_t* aC = CM + (kab * 32 + r) * 72 + 8 * hi; const LAS bf16_t* aS = SM + (kab * 32 + r) * 72 + 8 * hi;
          const LAS bf16_t* bA = AT + (mb * 32 + r) * 72 + 8 * hi; const LAS bf16_t* bB = BT + (mb * 32 + r) * 72 + 8 * hi;
          mma64(zr, aC, bA); mma64(zr, aS, bB); mma64(z1, aC, bB); mma64(z2, aS, bA);
          const int ta = tab * 8 + it * 2 + set, m = mb * 32 + r;
#pragma unroll
          for (int reg = 0; reg < 16; ++reg) { const int ka = kab * 32 + ACC_ROW(reg, hi), idx = (ta * ka) & 4095; const float cs = COST[idx], sn = COST[(idx + 3072) & 4095];
              const float re = zr[reg], im = z1[reg] - z2[reg];
              bf16_t* o = FZ + ((((size_t)(b * 4 + g) * 64 + ta) * 64 + ka) * 2) * 64 + m;
              o[0] = (bf16_t)f2bf(re * cs + im * sn); o[64] = (bf16_t)f2bf(im * cs - re * sn); } }
    }
    __syncthreads();
}
__device__ __forceinline__ void fourier_f2(const Params& p, LAS unsigned char* L, int b, int g, int kap) {
    const int tid = tid_opaque(), lane = tid & 63, wave = tid >> 6, r = lane & 31, hi = lane >> 5;
    const bf16_t* FZ = (const bf16_t*)(p.ws + WS_FZ);
    const LAS bf16_t* CM = (const LAS bf16_t*)(L + TAB_OFF); const LAS bf16_t* SM = (const LAS bf16_t*)(L + TAB_OFF + 9216);
#pragma unroll
    for (int j = 0; j < 4; ++j) { const int piece = tid + NTHREADS * j, set = piece >> 10, pp = piece & 1023, ta = pp >> 4, ri = (pp >> 3) & 1, mq = pp & 7, ka = kap * 2 + set;
        const u32x4 v = *(const u32x4*)(FZ + ((((size_t)(b * 4 + g) * 64 + ta) * 64 + ka) * 2 + ri) * 64 + mq * 8);
        LAS bf16_t* ZT = (LAS bf16_t*)(L + set * 18432 + ri * 9216);
#pragma unroll
        for (int i = 0; i < 8; ++i) ZT[(mq * 8 + i) * 72 + ta] = (bf16_t)((i & 1) ? (v[i >> 1] >> 16) : (v[i >> 1] & 0xffffu)); }
    __syncthreads();
    { const int set = wave >> 2, wl = wave & 3, kbb = wl & 1, mb = wl >> 1, ka = kap * 2 + set;
      const LAS bf16_t* ZR = (const LAS bf16_t*)(L + set * 18432); const LAS bf16_t* ZI = ZR + 4608;
      f32x16 acc = ZERO16;
      mma64(acc, CM + (kbb * 32 + r) * 72 + 8 * hi, ZR + (mb * 32 + r) * 72 + 8 * hi); mma64(acc, SM + (kbb * 32 + r) * 72 + 8 * hi, ZI + (mb * 32 + r) * 72 + 8 * hi);
      bf16_t* Y = (bf16_t*)(p.ws + WS_HY);
#pragma unroll
      for (int reg = 0; reg < 16; ++reg) { const int kb = kbb * 32 + ACC_ROW(reg, hi); Y[(size_t)(b * 4096 + ka + 64 * kb) * D + 512 + g * 64 + mb * 32 + r] = (bf16_t)f2bf(acc[reg] * (1.f / 512.f)); } }
    __syncthreads();
}
__device__ __forceinline__ void fourier_ctx(const Params& p, LAS unsigned char* L, int b, int g, int mq) {
    const int tid = tid_opaque();
    const bf16_t* Z = (const bf16_t*)(p.ws + WS_A);
    LAS bf16_t* XC = (LAS bf16_t*)L; LAS float* AC = (LAS float*)(L + 32768); LAS float* BC = (LAS float*)(L + 49152); const LAS float* COST = (const LAS float*)(L + TAB_OFF + 18432);
#pragma unroll
    for (int j = 0; j < 4; ++j) { const int piece = tid + NTHREADS * j, t = piece >> 3, cq = piece & 7;
        *(LAS u32x4*)(XC + t * 64 + cq * 8) = *(const u32x4*)(Z + (size_t)(NLAT + b * 256 + t) * NIN + OFF_F + g * 64 + cq * 8); }
    __syncthreads();
    const int mi = tid & 15, m = mq * 16 + mi, t0 = tid >> 4;
    for (int j = 0; j < 8; ++j) { const int t = t0 + 32 * j; float a = 0.f, bi = 0.f;
        for (int c = 0; c < 64; ++c) { const float x = bf1(XC[t * 64 + c]); const int idx = ((m * c) & 63) * 64; a += x * COST[idx]; bi -= x * COST[(idx + 3072) & 4095]; }
        AC[t * 16 + mi] = a; BC[t * 16 + mi] = bi; }
    __syncthreads();
    float acc[8];
#pragma unroll
    for (int j = 0; j < 8; ++j) acc[j] = 0.f;
    for (int t = 0; t < 256; ++t) { const float a = AC[t * 16 + mi], bi = BC[t * 16 + mi];
#pragma unroll
        for (int j = 0; j < 8; ++j) { const int k = t0 + 32 * j, idx = ((k * t) & 255) * 16; acc[j] += COST[idx] * a + COST[(idx + 3072) & 4095] * bi; } }
    bf16_t* Y = (bf16_t*)(p.ws + WS_HY);
#pragma unroll
    for (int j = 0; j < 8; ++j) { const int k = t0 + 32 * j; Y[(size_t)(NLAT + b * 256 + k) * D + 512 + g * 64 + m] = (bf16_t)f2bf(acc[j] * (1.f / 128.f)); }
    __syncthreads();
}

constexpr int NPHASES = 2 + 9 * DEPTH;
__global__ void __launch_bounds__(NTHREADS, 2) mega_fwd(Params p) {
    extern __shared__ __attribute__((aligned(16))) unsigned char lds_raw[];
    LAS unsigned char* L = (LAS unsigned char*)lds_raw;
    cg::grid_group grid = cg::this_grid();
    unsigned char* ws = p.ws;
    const float* MOD = (const float*)(ws + WS_MOD);
    const int G = gridDim.x, bx = blockIdx.x;
    for (int ph = p.ph_lo; ph < p.ph_hi; ++ph) {
        if (ph == 0) phase_prologue(p, L);
        else if (ph != 1) {
            const int l = (ph - 2) / 9, sub = (ph - 2) % 9; const bool last = (l == DEPTH - 1);
            const int mrows = last ? NLAT : MROWS, nchunk = last ? 512 : NCHUNK;
            const float* modl = MOD + (size_t)l * 9 * 6144;
            const float* xlat = (l == 0) ? p.in[I_X] : p.out; const float* xctx = (l == 0) ? p.in[I_CTX] : (const float*)(ws + WS_XC);
            switch (sub) {
            case 0: { pg8::Gemm g{(const bf16_t*)(ws + WS_HY), (const bf16_t*)(ws + WS_WIN) + (size_t)l * NINP * D, MROWS, NINP, D}; pg8::StaticOrder S; S.init(MROWS, NINP, G, bx);
                      pg8::EpiBf16N E{(bf16_t*)(ws + WS_A), NIN, NIN}; pg8::gemm_phase<pg8::EpiBf16N, pg8::StaticOrder, true, true>(L, g, S, E); } break;
            case 1: { fourier_tables(L);
                      for (int j = bx; j < 256; j += G) fourier_f1(p, L, j >> 5, (j >> 3) & 3, j & 7);
                      if (!last) for (int j = (bx + 128) % G; j < 128; j += G) fourier_ctx(p, L, j >> 4, (j >> 2) & 3, j & 3);
                      for (int j = bx; j < NCHUNK * 4; j += G) gla_g1(p, L, l, j >> 2, j & 3);
                      for (int j = (bx + 128) % G; j < NCHUNK * 4; j += G) rg_item<false>(p, L, l, j >> 2, j & 3); } break;
            case 2: { fourier_tables(L);
                      for (int j = bx; j < 256; j += G) gla_g2(p, j);
                      for (int j = bx; j < 8; j += G) rg_r2(p, j);
                      for (int j = bx; j < 1024; j += G) fourier_f2(p, L, j >> 7, (j >> 5) & 3, j & 31); } break;
            case 3: { const int nG = nchunk * 4;
                      for (int j = bx; j < nG; j += G) gla_g3(p, L, l, j >> 2, j & 3);
                      for (int j = (bx + 128) % G; j < nG; j += G) rg_item<true>(p, L, l, j >> 2, j & 3); } break;
            case 4: { pg8::Gemm g{(const bf16_t*)(ws + WS_HY), (const bf16_t*)(ws + WS_WOUT) + (size_t)l * D * D, mrows, D, D}; pg8::StaticOrder S; S.init(mrows, D, G, bx);
                      pg8::EpiF32 E{(float*)(ws + WS_B), D}; pg8::gemm_phase<pg8::EpiF32, pg8::StaticOrder, true, true>(L, g, S, E); } break;
            case 5: break;
            case 6: { pg8::Gemm g{(const bf16_t*)(ws + WS_HY), (const bf16_t*)(ws + WS_WGU) + (size_t)l * 2 * DFF * D, mrows, 2 * DFF, D}; pg8::StaticOrder S; S.init(mrows, 2 * DFF, G, bx);
                      pg8::EpiSwiGLU E{(bf16_t*)(ws + WS_A), DFF}; pg8::gemm_phase<pg8::EpiSwiGLU, pg8::StaticOrder, true, true>(L, g, S, E); } break;
            case 7: { pg8::Gemm g{(const bf16_t*)(ws + WS_A), (const bf16_t*)(ws + WS_WDN) + (size_t)l * D * DFF, mrows, D, DFF}; pg8::StaticOrder S; S.init(mrows, D, G, bx);
                      pg8::EpiF32 E{(float*)(ws + WS_B), D}; pg8::gemm_phase<pg8::EpiF32, pg8::StaticOrder, true, true>(L, g, S, E); } break;
            default: break;
            }
        }
        {
            const int l = (ph < 2) ? 0 : (ph - 2) / 9, sub = (ph < 2) ? -1 : (ph - 2) % 9; const bool last = (l == DEPTH - 1);
            if (ph == 1 || sub == 5 || sub == 8) {
                const bool has_t = (ph != 1), r2 = (sub == 8);
                const float* modl = MOD + (size_t)l * 9 * 6144;
                const float* xlat = (l == 0 && !r2) ? p.in[I_X] : p.out; const float* xctx = (l == 0 && !r2) ? p.in[I_CTX] : (const float*)(ws + WS_XC);
                const int lh = r2 ? (last ? l : l + 1) : l;
                rows_phase(p, has_t, (last && has_t) ? NLAT : MROWS, xlat, xctx, (const float*)(ws + WS_B), p.in[r2 ? I_GPOSTFFN : I_GPOSTMIX] + l * D, modl, r2 ? 5120 : 2048,
                           !(r2 && last), p.in[(sub == 5) ? I_GPREFFN : I_GPREMIX] + lh * D, MOD + (size_t)lh * 9 * 6144, (sub == 5) ? 3072 : 0, (sub == 5) ? 4096 : 1024);
            }
        }
        if (ph + 1 < p.ph_hi) grid.sync();
    }
}

#ifndef MK_SPLIT
#define MK_SPLIT 0
#endif
extern "C" void kernel_launch(void* const* d_in, const int* in_sizes, int n_in, void* d_out, int out_size, void* d_ws, size_t ws_size, hipStream_t stream) {
    static int grid = 0;
    if (grid == 0) {
        int dev = 0, cus = 0, per_cu = 0;
        if (n_in != 25 || ws_size < WS_END) { fprintf(stderr, "kernel_launch: unexpected inputs (n_in %d, ws %zu)\n", n_in, ws_size); grid = -1; return; }
        hipGetDevice(&dev); hipDeviceGetAttribute(&cus, hipDeviceAttributeMultiprocessorCount, dev);
        if (hipFuncSetAttribute((const void*)mega_fwd, hipFuncAttributeMaxDynamicSharedMemorySize, LDS_BYTES) != hipSuccess) fprintf(stderr, "kernel_launch: hipFuncSetAttribute failed\n");
        if (hipOccupancyMaxActiveBlocksPerMultiprocessor(&per_cu, (const void*)mega_fwd, NTHREADS, LDS_BYTES) != hipSuccess || per_cu < 1) { fprintf(stderr, "kernel_launch: occupancy query gave %d\n", per_cu); per_cu = 1; }
        (void)hipGetLastError();
        grid = cus * 1;
    }
    if (grid < 0) return;
    Params p{};
    for (int i = 0; i < 25; ++i) p.in[i] = (const float*)d_in[i];
    p.out = (float*)d_out; p.ws = (unsigned char*)d_ws;
#if MK_SPLIT
    for (int ph = 0; ph < NPHASES; ++ph) { p.ph_lo = ph; p.ph_hi = ph + 1; hipLaunchKernelGGL(mega_fwd, dim3(grid), dim3(NTHREADS), LDS_BYTES, stream, p); }
#else
    p.ph_lo = 0; p.ph_hi = NPHASES;
    void* args[] = {&p};
    hipError_t e = hipLaunchCooperativeKernel((const void*)mega_fwd, dim3(grid), dim3(NTHREADS), args, LDS_BYTES, stream);
    if (e != hipSuccess) fprintf(stderr, "kernel_launch: cooperative launch failed: %s (grid %d)\n", hipGetErrorString(e), grid);
#endif
}
```

```cpp
#include <hip/hip_runtime.h>
#include <hip/hip_cooperative_groups.h>
#include <cstdio>
#include <cstdint>
namespace cg = cooperative_groups;
namespace pg8 {
#define PG8_LAS __attribute__((address_space(3)))
typedef unsigned short bf16_t;
typedef short bf16x8 __attribute__((ext_vector_type(8)));
typedef float f32x4 __attribute__((ext_vector_type(4)));
typedef unsigned u32x4 __attribute__((ext_vector_type(4)));
constexpr int BM = 256, BK = 64, HALF = 128, HTB = HALF * BK * 2  , STAGE_BYTES = 8 * HTB, NXCD = 8, WGM = 8;

__host__ __device__ __forceinline__ int lds_byte(int r, int c) { const int st = (r >> 4) * 2 + (c >> 5), rr = r & 15, cc = c & 31, ob = rr * 64 + cc * 2; return st * 1024 + (ob ^ (((ob >> 9) & 1) << 5)); }
__host__ __device__ __forceinline__ void stage_rc(int b, int& R, int& C) { const int st = b / 1024, sb = b % 1024, swz = sb ^ (((sb >> 9) & 1) << 5); R = (st >> 1) * 16 + swz / 64; C = (st & 1) * 32 + (swz % 64) / 2; }
__host__ __device__ __forceinline__ int perm32(int rho) { const int n = rho >> 4, i = rho & 15; return 8 * (i >> 2) + 4 * n + (i & 3); }

struct Unit { int pm, pn; };
struct Gemm { const bf16_t* A; const bf16_t* Bt; int M, N, K; };

struct StaticOrder {
    int nM, nN, nwg, G, c;
    __host__ __device__ void init(int M, int N, int G_, int c_) { nM = M / BM; nN = N / BM; nwg = nM * nN; G = G_; c = c_; }
    __host__ __device__ bool next(int i, Unit& u) const {
        const long L = (long)i * G + c; if (L >= nwg) return false;
        int wgid = (int)L; { const int q = nwg / NXCD, r = nwg % NXCD, xcd = wgid % NXCD, off = wgid / NXCD; wgid = (xcd < r ? xcd * (q + 1) : r * (q + 1) + (xcd - r) * q) + off; }
        const int nig = WGM * nN, gid = wgid / nig, fm = gid * WGM, gsz = (nM - fm) < WGM ? (nM - fm) : WGM;
        u.pm = fm + ((wgid % nig) % gsz); u.pn = (wgid % nig) / gsz; return true;
    }
    __device__ __forceinline__ void a_ready(const Unit&) const {}
    __device__ __forceinline__ void done(const Unit&) const {}
};

__device__ __forceinline__ unsigned cvt_pk_bf16(float lo, float hi) { unsigned r; asm volatile("v_cvt_pk_bf16_f32 %0, %1, %2" : "=v"(r) : "v"(lo), "v"(hi)); return r; }
typedef float f32x2 __attribute__((ext_vector_type(2)));
struct EpiBf16N {
    static constexpr bool PERM = true, AFTER_DRAIN = false;
    bf16_t* O; int ldc; int nvalid;
    __device__ __forceinline__ void operator()(const f32x4 (&acc)[2][2][4][2], const Unit& u, int wr, int wc, int fr, int fq) const {
        const int row0 = u.pm * BM + wr * 64 + fr, col0 = u.pn * BM + wc * 32 + 8 * fq;
#pragma unroll
        for (int ai = 0; ai < 2; ++ai)
#pragma unroll
            for (int m = 0; m < 4; ++m) { bf16_t* rowp = O + (size_t)(row0 + ai * HALF + m * 16) * ldc;
#pragma unroll
                for (int bj = 0; bj < 2; ++bj) { const int c = col0 + bj * HALF; const f32x4 v0 = acc[ai][bj][m][0], v1 = acc[ai][bj][m][1];
                    u32x4 w; w.x = cvt_pk_bf16(v0[0], v0[1]); w.y = cvt_pk_bf16(v0[2], v0[3]); w.z = cvt_pk_bf16(v1[0], v1[1]); w.w = cvt_pk_bf16(v1[2], v1[3]);
                    if (c < nvalid) *(u32x4*)(rowp + c) = w; } }
    }
};
struct EpiF32 {
    static constexpr bool PERM = true, AFTER_DRAIN = false;
    float* O; int ldc;
    __device__ __forceinline__ void operator()(const f32x4 (&acc)[2][2][4][2], const Unit& u, int wr, int wc, int fr, int fq) const {
        const int row0 = u.pm * BM + wr * 64 + fr, col0 = u.pn * BM + wc * 32 + 8 * fq;
#pragma unroll
        for (int ai = 0; ai < 2; ++ai)
#pragma unroll
            for (int m = 0; m < 4; ++m) { float* rowp = O + (size_t)(row0 + ai * HALF + m * 16) * ldc + col0;
#pragma unroll
                for (int bj = 0; bj < 2; ++bj) { *(f32x4*)(rowp + bj * HALF) = acc[ai][bj][m][0]; *(f32x4*)(rowp + bj * HALF + 4) = acc[ai][bj][m][1]; } }
    }
};
struct EpiSwiGLU {
    static constexpr bool PERM = true, AFTER_DRAIN = false;
    bf16_t* O; int ldc;
    __device__ __forceinline__ void operator()(const f32x4 (&acc)[2][2][4][2], const Unit& u, int wr, int wc, int fr, int fq) const {
        const int row0 = u.pm * BM + wr * 64 + fr, col0 = u.pn * HALF + wc * 32 + 8 * fq;
#pragma unroll
        for (int ai = 0; ai < 2; ++ai)
#pragma unroll
            for (int m = 0; m < 4; ++m) { bf16_t* rowp = O + (size_t)(row0 + ai * HALF + m * 16) * ldc + col0;
                float h[8];
#pragma unroll
                for (int n = 0; n < 2; ++n)
#pragma unroll
                    for (int j = 0; j < 4; ++j) { const float g = acc[ai][0][m][n][j], up = acc[ai][1][m][n][j]; h[n * 4 + j] = g * __builtin_amdgcn_rcpf(1.f + __expf(-g)) * up; }
                u32x4 w; w.x = cvt_pk_bf16(h[0], h[1]); w.y = cvt_pk_bf16(h[2], h[3]); w.z = cvt_pk_bf16(h[4], h[5]); w.w = cvt_pk_bf16(h[6], h[7]);
                *(u32x4*)rowp = w; }
    }
};
template <class Epi, class Sched, bool ALIGN_EPI = false, bool SP2 = false>
__device__ __forceinline__ void gemm_phase(PG8_LAS unsigned char* lds, const Gemm g, const Sched& S, const Epi& E) {
    int tid = threadIdx.x; asm volatile("" : "+v"(tid)); const int wid = __builtin_amdgcn_readfirstlane(tid >> 6), lane = tid & 63, wr = wid >> 2, wc = wid & 3, fr = lane & 15, fq = lane >> 4;
    const int K = g.K, nt = K / BK;
    unsigned voffA[2], voffB[2];
#pragma unroll
    for (int i = 0; i < 2; ++i) { int R, C; stage_rc(tid * 16 + i * 8192, R, C); const int Rb = Epi::PERM ? ((R & ~31) + perm32(R & 31)) : R;
        voffA[i] = (unsigned)(R * K + C) * 2u; voffB[i] = (unsigned)(Rb * K + C) * 2u; }
    const size_t kstep = (size_t)(BK * 2);
    const size_t hstep = (size_t)HALF * K * 2;
    const size_t tstep = 2 * hstep;
    const unsigned ldsw = (unsigned)wid * 1024u;
    const int aoff = lds_byte(wr * 64 + fr, fq * 8), boff = lds_byte(wc * 32 + fr, fq * 8);
#define PG8_SA(b, h) (((b) * 2 + (h)) * HTB)
#define PG8_SB(b, h) ((4 + (b) * 2 + (h)) * HTB)
#define PG8_STAGE(bufoff, gbase, voff) do { _Pragma("unroll") for (int _i = 0; _i < 2; ++_i) \
        __builtin_amdgcn_global_load_lds((const unsigned*)((const char*)(gbase) + (voff)[_i]), (PG8_LAS unsigned*)(lds + (bufoff) + ldsw + _i * 8192), 16, 0, 0); } while (0)
#define PG8_LDA(dst, b, h) do { _Pragma("unroll") for (int m = 0; m < 4; ++m) _Pragma("unroll") for (int k = 0; k < 2; ++k) dst[m][k] = *(const PG8_LAS bf16x8*)(lds + PG8_SA(b, h) + aoff + m * 2048 + k * 1024); } while (0)
#define PG8_LDB(dst, b, h) do { _Pragma("unroll") for (int n = 0; n < 2; ++n) _Pragma("unroll") for (int k = 0; k < 2; ++k) dst[n][k] = *(const PG8_LAS bf16x8*)(lds + PG8_SB(b, h) + boff + n * 2048 + k * 1024); } while (0)
#define PG8_MMA(ai, bj, At, Bt) do { __builtin_amdgcn_s_setprio(1); _Pragma("unroll") for (int m = 0; m < 4; ++m) _Pragma("unroll") for (int n = 0; n < 2; ++n) _Pragma("unroll") for (int k = 0; k < 2; ++k) \
        acc[ai][bj][m][n] = __builtin_amdgcn_mfma_f32_16x16x32_bf16(Bt[n][k], At[m][k], acc[ai][bj][m][n], 0, 0, 0); __builtin_amdgcn_s_setprio(0); } while (0)
#define PG8_WAIT_V(n) asm volatile("s_waitcnt vmcnt(" #n ")" ::: "memory")
#define PG8_WAIT_L(n) asm volatile("s_waitcnt lgkmcnt(" #n ")" ::: "memory")
#define PG8_BAR __builtin_amdgcn_s_barrier()
#define PG8_SCHED __builtin_amdgcn_sched_barrier(0)
    Unit cur, nxt; int ui = 0;
    if (!S.next(0, cur)) return;
    f32x4 acc[2][2][4][2];
#pragma unroll
    for (int a = 0; a < 2; ++a)
#pragma unroll
        for (int b = 0; b < 2; ++b)
#pragma unroll
            for (int m = 0; m < 4; ++m)
#pragma unroll
                for (int n = 0; n < 2; ++n) acc[a][b][m][n] = (f32x4){0.f, 0.f, 0.f, 0.f};
    bf16x8 At[4][2], B0[2][2], B1[2][2];
    const char* cA = (const char*)g.A + (size_t)cur.pm * tstep; const char* cB = (const char*)g.Bt + (size_t)cur.pn * tstep;
    S.a_ready(cur);
    if constexpr (SP2) {
        PG8_STAGE(PG8_SB(0, 0), cB, voffB); PG8_STAGE(PG8_SB(0, 1), cB + hstep, voffB); PG8_STAGE(PG8_SA(0, 0), cA, voffA); PG8_STAGE(PG8_SA(0, 1), cA + hstep, voffA);
        if (wr == 1) PG8_BAR;
        PG8_WAIT_V(2); PG8_BAR;
        PG8_STAGE(PG8_SB(1, 0), cB + kstep, voffB); PG8_STAGE(PG8_SA(1, 0), cA + kstep, voffA); PG8_STAGE(PG8_SB(1, 1), cB + hstep + kstep, voffB);
        PG8_WAIT_V(6); PG8_BAR;
    } else {
        PG8_STAGE(PG8_SB(0, 0), cB, voffB); PG8_STAGE(PG8_SA(0, 0), cA, voffA); PG8_STAGE(PG8_SB(0, 1), cB + hstep, voffB); PG8_STAGE(PG8_SA(0, 1), cA + hstep, voffA);
        if (wr == 1) PG8_BAR;
        PG8_WAIT_V(4); PG8_BAR;
        PG8_STAGE(PG8_SB(1, 0), cB + kstep, voffB); PG8_STAGE(PG8_SA(1, 0), cA + kstep, voffA); PG8_STAGE(PG8_SB(1, 1), cB + hstep + kstep, voffB);
        PG8_WAIT_V(6); PG8_BAR;
    }
    for (;;) {
        const bool has_next = S.next(ui + 1, nxt);
        const char* nA = has_next ? (const char*)g.A + (size_t)nxt.pm * tstep : cA; const char* nB = has_next ? (const char*)g.Bt + (size_t)nxt.pn * tstep : cB;
        for (int t = 0; t < nt; t += 2) {
            const bool last = (t == nt - 2);
            const char* a1 = cA + (size_t)(t + 1) * kstep;
            const char* a2 = last ? nA : cA + (size_t)(t + 2) * kstep; const char* b2 = last ? nB : cB + (size_t)(t + 2) * kstep;
            const char* a3 = a2 + kstep; const char* b3 = b2 + kstep;
            if (last && has_next) S.a_ready(nxt);
            if constexpr (SP2) {
            PG8_LDB(B0, 0, 0); PG8_LDB(B1, 0, 1); PG8_SCHED; PG8_LDA(At, 0, 0); PG8_STAGE(PG8_SA(1, 1), a1 + hstep, voffA);
            PG8_WAIT_V(8); PG8_WAIT_L(0); PG8_BAR; PG8_MMA(0, 0, At, B0); PG8_MMA(0, 1, At, B1); PG8_BAR; PG8_SCHED;
            PG8_LDA(At, 0, 1); PG8_STAGE(PG8_SB(0, 0), b2, voffB); PG8_STAGE(PG8_SB(0, 1), b2 + hstep, voffB); PG8_STAGE(PG8_SA(0, 0), a2, voffA);
            PG8_WAIT_V(8); PG8_WAIT_L(0); PG8_BAR; PG8_MMA(1, 0, At, B0); PG8_MMA(1, 1, At, B1); PG8_BAR; PG8_SCHED;
            PG8_LDB(B0, 1, 0); PG8_LDB(B1, 1, 1); PG8_SCHED; PG8_LDA(At, 1, 0); PG8_STAGE(PG8_SA(0, 1), a2 + hstep, voffA);
            PG8_WAIT_V(8); PG8_WAIT_L(0); PG8_BAR; PG8_MMA(0, 0, At, B0); PG8_MMA(0, 1, At, B1); PG8_BAR; PG8_SCHED;
            PG8_LDA(At, 1, 1); PG8_STAGE(PG8_SB(1, 0), b3, voffB); PG8_STAGE(PG8_SB(1, 1), b3 + hstep, voffB); PG8_STAGE(PG8_SA(1, 0), a3, voffA);
            PG8_WAIT_V(8); PG8_WAIT_L(0); PG8_BAR; PG8_MMA(1, 0, At, B0); PG8_MMA(1, 1, At, B1); PG8_BAR; PG8_SCHED;
            } else {
            PG8_LDB(B0, 0, 0); PG8_SCHED; PG8_LDA(At, 0, 0); PG8_STAGE(PG8_SA(1, 1), a1 + hstep, voffA);
            PG8_WAIT_L(8); PG8_BAR; PG8_WAIT_L(0); PG8_MMA(0, 0, At, B0); PG8_BAR; PG8_SCHED;
            PG8_LDB(B1, 0, 1); PG8_STAGE(PG8_SB(0, 0), b2, voffB);
            PG8_BAR; PG8_WAIT_L(0); PG8_MMA(0, 1, At, B1); PG8_BAR;
            PG8_LDA(At, 0, 1); PG8_STAGE(PG8_SA(0, 0), a2, voffA);
            PG8_BAR; PG8_WAIT_L(0); PG8_MMA(1, 0, At, B0); PG8_BAR; PG8_SCHED;
            PG8_STAGE(PG8_SB(0, 1), b2 + hstep, voffB);
            PG8_WAIT_V(6); PG8_BAR; PG8_MMA(1, 1, At, B1); PG8_BAR;
            PG8_LDB(B0, 1, 0); PG8_SCHED; PG8_LDA(At, 1, 0); PG8_STAGE(PG8_SA(0, 1), a2 + hstep, voffA);
            PG8_WAIT_L(8); PG8_BAR; PG8_WAIT_L(0); PG8_MMA(0, 0, At, B0); PG8_BAR; PG8_SCHED;
            PG8_LDB(B1, 1, 1); PG8_STAGE(PG8_SB(1, 0), b3, voffB);
            PG8_BAR; PG8_WAIT_L(0); PG8_MMA(0, 1, At, B1); PG8_BAR;
            PG8_LDA(At, 1, 1); PG8_STAGE(PG8_SA(1, 0), a3, voffA);
            PG8_BAR; PG8_WAIT_L(0); PG8_MMA(1, 0, At, B0); PG8_BAR; PG8_SCHED;
            PG8_STAGE(PG8_SB(1, 1), b3 + hstep, voffB);
            PG8_WAIT_V(6); PG8_BAR; PG8_MMA(1, 1, At, B1); PG8_BAR;
            }
        }
        if constexpr (ALIGN_EPI) { if (wr == 0) PG8_BAR; }
        if constexpr (!Epi::AFTER_DRAIN) { E(acc, cur, wr, wc, fr, fq); S.done(cur); }
        if (!has_next) break;
#pragma unroll
        for (int a = 0; a < 2; ++a)
#pragma unroll
            for (int b = 0; b < 2; ++b)
#pragma unroll
                for (int m = 0; m < 4; ++m)
#pragma unroll
                    for (int n = 0; n < 2; ++n) acc[a][b][m][n] = (f32x4){0.f, 0.f, 0.f, 0.f};
        cur = nxt; cA = nA; cB = nB; ++ui;
        if constexpr (ALIGN_EPI) { if (wr == 1) PG8_BAR; }
    }
    PG8_WAIT_V(0);
    if constexpr (!ALIGN_EPI) { if (wr == 0) PG8_BAR; }
    PG8_BAR;
    if constexpr (Epi::AFTER_DRAIN) { E.fused(acc, cur, wr, wc, fr, fq, lds, wid, lane); S.done(cur); }
#undef PG8_SA
#undef PG8_SB
#undef PG8_STAGE
#undef PG8_LDA
#undef PG8_LDB
#undef PG8_MMA
#undef PG8_WAIT_V
#undef PG8_WAIT_L
#undef PG8_BAR
#undef PG8_SCHED
}
}
#define LAS __attribute__((address_space(3)))
typedef unsigned short bf16_t;
typedef short bf16x8 __attribute__((ext_vector_type(8)));
typedef float f32x4 __attribute__((ext_vector_type(4)));
typedef float f32x16 __attribute__((ext_vector_type(16)));
typedef unsigned u32x4 __attribute__((ext_vector_type(4)));
typedef unsigned u32x2 __attribute__((ext_vector_type(2)));

constexpr int D = 1024, NB = 8, SEQ = 4096, CTX = 256, DEPTH = 4;
constexpr int NLAT = NB * SEQ, NCTX = NB * CTX, MROWS = NLAT + NCTX;
constexpr int NIN = 2336, NINP = 2560, DFF = 2816;
constexpr int OFF_Q = 0, OFF_K = 256, OFF_V = 512, OFF_DEC = 1024, OFF_OG = 1056, OFF_F = 1568, OFF_RX = 1824, OFF_RG = 2080;
constexpr int NCHUNK = MROWS / 64;
constexpr float EPS = 1e-6f;
constexpr int NTHREADS = 512, NWAVES = 8;
constexpr int LDS_BYTES = 147456 + 256;
constexpr int MISC_OFF = 147456;
constexpr int TAB_OFF = 147456 - 34816;

constexpr size_t MiB = 1u << 20;
constexpr size_t WS_WIN = 0, WS_WOUT = 20 * MiB, WS_WGU = 28 * MiB, WS_WDN = 72 * MiB, WS_MOD = 94 * MiB, WS_WRG = 95 * MiB, WS_DEC = 96 * MiB,
                 WS_RGS = 98 * MiB, WS_HST = 101 * MiB, WS_XC = 103 * MiB, WS_HY = 111 * MiB, WS_A = 179 * MiB, WS_B = 366 * MiB, WS_FZ = 434 * MiB, WS_END = 502 * MiB, WS_CTL = 510 * MiB, CTL_BYTES = 16384;

struct Params { const float* in[25]; float* out; unsigned char* ws; int ph_lo, ph_hi; };
enum { I_X = 0, I_C, I_CTX, I_CCTX, I_WADA, I_BADA, I_GPREMIX, I_GPOSTMIX, I_GPREFFN, I_GPOSTFFN, I_WIN, I_WDEC, I_BDEC, I_GGLA, I_WCONV, I_BCONV,
       I_WRGA, I_BRGA, I_WRGX, I_BRGX, I_RGLAM, I_WOUT, I_WGATE, I_WUP, I_WDOWN };

__device__ __forceinline__ int tid_opaque() { int t = threadIdx.x; asm volatile("" : "+v"(t)); return t; }
__device__ __forceinline__ unsigned f2bf(float f) { unsigned u = __builtin_bit_cast(unsigned, f); return (u + 0x7fffu + ((u >> 16) & 1u)) >> 16; }
__device__ __forceinline__ unsigned pk2(float lo, float hi) { return f2bf(lo) | (f2bf(hi) << 16); }
__device__ __forceinline__ float bflo(unsigned w) { return __builtin_bit_cast(float, w << 16); }
__device__ __forceinline__ float bfhi(unsigned w) { return __builtin_bit_cast(float, w & 0xffff0000u); }
__device__ __forceinline__ float bf1(unsigned short h) { return __builtin_bit_cast(float, (unsigned)h << 16); }
#define BFE(v, i) (((i) & 1) ? bfhi((v)[(i) >> 1]) : bflo((v)[(i) >> 1]))
__device__ __forceinline__ float wave_sum(float v) {
#pragma unroll
    for (int o = 1; o < 64; o <<= 1) v += __shfl_xor(v, o);
    return v;
}
__device__ __forceinline__ float sigmoidf_(float x) { return __builtin_amdgcn_rcpf(1.f + __expf(-x)); }
__device__ __forceinline__ bf16x8 ldv(const LAS bf16_t* p) { return *(const LAS bf16x8*)p; }
__device__ __forceinline__ bf16x8 ldv(const bf16_t* p) { return *(const bf16x8*)p; }
template <class PA, class PB> __device__ __forceinline__ void mma64(f32x16& acc, PA a, PB b) {
#pragma unroll
    for (int k0 = 0; k0 < 64; k0 += 16) acc = __builtin_amdgcn_mfma_f32_32x32x16_bf16(ldv(a + k0), ldv(b + k0), acc, 0, 0, 0);
}
#define ACC_ROW(reg, hi) (((reg) & 3) + 8 * ((reg) >> 2) + 4 * (hi))
#define ZERO16 ((f32x16){0.f,0.f,0.f,0.f,0.f,0.f,0.f,0.f,0.f,0.f,0.f,0.f,0.f,0.f,0.f,0.f})

__device__ __forceinline__ void transpose_item(const float* W, int N, bf16_t* WT, int ldk, int k0, int n0, int drow0, LAS float* scr, int lane) {
#pragma unroll 8
    for (int i = 0; i < 32; ++i) { const int kk = 2 * i + (lane >> 5); scr[kk * 33 + (lane & 31)] = W[(size_t)(k0 + kk) * N + n0 + (lane & 31)]; }
    asm volatile("s_waitcnt lgkmcnt(0)" ::: "memory");
    const int c = lane & 7;
#pragma unroll
    for (int j = 0; j < 4; ++j) { const int n = (lane >> 3) + 8 * j; const LAS float* s = scr + (8 * c) * 33 + n;
        u32x4 o; o.x = pk2(s[0 * 33], s[1 * 33]); o.y = pk2(s[2 * 33], s[3 * 33]); o.z = pk2(s[4 * 33], s[5 * 33]); o.w = pk2(s[6 * 33], s[7 * 33]);
        *(u32x4*)(WT + (size_t)(drow0 + n) * ldk + k0 + 8 * c) = o; }
    asm volatile("s_waitcnt lgkmcnt(0)" ::: "memory");
}

__device__ __forceinline__ void phase_prologue(const Params& p, LAS unsigned char* L) {
    const int tid = tid_opaque(), lane = tid & 63, wave = tid >> 6;
    unsigned char* ws = p.ws;
    {
        LAS float* scr = (LAS float*)(L + wave * 16384);
        const int gw = blockIdx.x * NWAVES + wave, NGW = gridDim.x * NWAVES;
        constexpr int I_IN = 16 * 73, I_OUT = 16 * 32, I_G = 16 * 88, I_DN = 44 * 32, I_L = I_IN + I_OUT + 2 * I_G + I_DN;
        for (int it = gw; it < DEPTH * I_L; it += NGW) {
            const int l = it / I_L; int r = it % I_L;
            if (r < I_IN) { const int kb = r / 73, nb = r % 73; transpose_item(p.in[I_WIN] + (size_t)l * D * NIN, NIN, (bf16_t*)(ws + WS_WIN) + (size_t)l * NINP * D, D, kb * 64, nb * 32, nb * 32, scr, lane); continue; }
            r -= I_IN;
            if (r < I_OUT) { const int kb = r / 32, nb = r % 32; transpose_item(p.in[I_WOUT] + (size_t)l * D * D, D, (bf16_t*)(ws + WS_WOUT) + (size_t)l * D * D, D, kb * 64, nb * 32, nb * 32, scr, lane); continue; }
            r -= I_OUT;
            if (r < 2 * I_G) { const int up = r >= I_G; if (up) r -= I_G; const int kb = r / 88, nb = r % 88, n0 = nb * 32;
                transpose_item(p.in[up ? I_WUP : I_WGATE] + (size_t)l * D * DFF, DFF, (bf16_t*)(ws + WS_WGU) + (size_t)l * 2 * DFF * D, D, kb * 64, n0, 256 * (n0 >> 7) + (n0 & 127) + (up ? 128 : 0), scr, lane); continue; }
            r -= 2 * I_G;
            { const int kb = r / 32, nb = r % 32; transpose_item(p.in[I_WDOWN] + (size_t)l * DFF * D, D, (bf16_t*)(ws + WS_WDN) + (size_t)l * D * DFF, DFF, kb * 64, nb * 32, nb * 32, scr, lane); }
        }
        const int gt = blockIdx.x * NTHREADS + tid, NGT = gridDim.x * NTHREADS;
        constexpr int PADV = (NINP - NIN) * D / 8;
        for (int i = gt; i < DEPTH * PADV; i += NGT) { const int l = i / PADV, q = i % PADV;
            *(u32x4*)((bf16_t*)(ws + WS_WIN) + (size_t)l * NINP * D + (size_t)NIN * D + (size_t)q * 8) = (u32x4){0u, 0u, 0u, 0u}; }
        for (int i = gt; i < DEPTH * 2 * 2 * 4 * 4096; i += NGT) {
            const int in_ = i & 63, out_ = (i >> 6) & 63, head = (i >> 12) & 3, ax = (i >> 14) & 1, dir = (i >> 15) & 1, l = i >> 16;
            const float* W = p.in[ax ? I_WRGX : I_WRGA];
            ((bf16_t*)(ws + WS_WRG))[i] = (bf16_t)f2bf(W[((((size_t)l * 2 + dir) * 4 + head) * 64 + in_) * 64 + out_]);
        }
    }
    __syncthreads();
    {
        LAS float* sl = (LAS float*)L;
        LAS float* red = (LAS float*)(L + 36864);
        for (int i = tid; i < 9 * 1024; i += NTHREADS) { const int r = i >> 10, k = i & 1023; const float v = (r < 8) ? p.in[I_C][r * 1024 + k] : p.in[I_CCTX][k]; sl[i] = v / (1.f + __expf(-v)); }
        __syncthreads();
        float* MOD = (float*)(ws + WS_MOD);
        for (int item = blockIdx.x; item < DEPTH * 96; item += gridDim.x) {
            const int l = item / 96, cb = item % 96, cc = tid & 63, kg = tid >> 6;
            const float* w = p.in[I_WADA] + ((size_t)l * 1024 + kg * 128) * 6144 + cb * 64 + cc;
            float a0 = 0.f, a1 = 0.f, a2 = 0.f, a3 = 0.f, a4 = 0.f, a5 = 0.f, a6 = 0.f, a7 = 0.f, a8 = 0.f;
            const LAS float* s = sl + kg * 128;
#pragma unroll 8
            for (int k = 0; k < 128; ++k) { const float wv = w[(size_t)k * 6144];
                a0 += s[k] * wv; a1 += s[1024 + k] * wv; a2 += s[2048 + k] * wv; a3 += s[3072 + k] * wv; a4 += s[4096 + k] * wv;
                a5 += s[5120 + k] * wv; a6 += s[6144 + k] * wv; a7 += s[7168 + k] * wv; a8 += s[8192 + k] * wv; }
            LAS float* rp = red + kg * 576 + cc;
            rp[0] = a0; rp[64] = a1; rp[128] = a2; rp[192] = a3; rp[256] = a4; rp[320] = a5; rp[384] = a6; rp[448] = a7; rp[512] = a8;
            __syncthreads();
            for (int i = tid; i < 576; i += NTHREADS) { float sum = 0.f;
#pragma unroll
                for (int g = 0; g < 8; ++g) sum += red[g * 576 + i];
                const int r = i >> 6, c2 = i & 63; MOD[((size_t)l * 9 + r) * 6144 + cb * 64 + c2] = sum + p.in[I_BADA][l * 6144 + cb * 64 + c2]; }
            __syncthreads();
        }
    }
}

__device__ __forceinline__ void rows_phase(const Params& p, const bool HAS_T, int nrows, const float* xlat_src, const float* xctx_src, const float* T, const float* gpost, const float* modT, int gt_off,
                                           bool want_h, const float* gpre, const float* modH, int sh_off, int sc_off) {
    const int tid = tid_opaque(), lane = tid & 63, wave = tid >> 6;
    const int gw = blockIdx.x * NWAVES + wave, NGW = gridDim.x * NWAVES;
    float* xlat_dst = p.out; float* xctx_dst = (float*)(p.ws + WS_XC); bf16_t* H = (bf16_t*)(p.ws + WS_HY);
    for (int row = gw; row < nrows; row += NGW) {
        const bool isctx = row >= NLAT; const int mrow = isctx ? 8 : (row >> 12);
        const float* xs = isctx ? xctx_src + (size_t)(row - NLAT) * D : xlat_src + (size_t)row * D;
        f32x4 x[4];
#pragma unroll
        for (int j = 0; j < 4; ++j) x[j] = *(const f32x4*)(xs + 4 * lane + 256 * j);
        if (HAS_T) {
            f32x4 t[4]; float ss = 0.f;
#pragma unroll
            for (int j = 0; j < 4; ++j) { t[j] = *(const f32x4*)(T + (size_t)row * D + 4 * lane + 256 * j); ss += t[j].x * t[j].x + t[j].y * t[j].y + t[j].z * t[j].z + t[j].w * t[j].w; }
            const float rstd = rsqrtf(wave_sum(ss) * (1.f / D) + EPS);
            const float* mt = modT + (size_t)mrow * 6144 + gt_off;
            float* xd = isctx ? xctx_dst + (size_t)(row - NLAT) * D : xlat_dst + (size_t)row * D;
#pragma unroll
            for (int j = 0; j < 4; ++j) { const f32x4 g = *(const f32x4*)(gpost + 4 * lane + 256 * j), gt = *(const f32x4*)(mt + 4 * lane + 256 * j);
                x[j] = x[j] + gt * (t[j] * rstd * g); *(f32x4*)(xd + 4 * lane + 256 * j) = x[j]; }
        }
        if (want_h) {
            float ss = 0.f;
#pragma unroll
            for (int j = 0; j < 4; ++j) ss += x[j].x * x[j].x + x[j].y * x[j].y + x[j].z * x[j].z + x[j].w * x[j].w;
            const float rstd = rsqrtf(wave_sum(ss) * (1.f / D) + EPS);
            const float* mh = modH + (size_t)mrow * 6144;
#pragma unroll
            for (int j = 0; j < 4; ++j) { const f32x4 g = *(const f32x4*)(gpre + 4 * lane + 256 * j), sh = *(const f32x4*)(mh + sh_off + 4 * lane + 256 * j), sc = *(const f32x4*)(mh + sc_off + 4 * lane + 256 * j);
                const f32x4 h = (x[j] * rstd * g) * (sc + 1.f) + sh;
                u32x2 o; o.x = pk2(h.x, h.y); o.y = pk2(h.z, h.w); *(u32x2*)(H + (size_t)row * D + 4 * lane + 256 * j) = o; }
        }
    }
}

__device__ __forceinline__ int scan_cid(int b, int dir, int s) { return (s < 4) ? (512 + b * 4 + (dir ? 3 - s : s)) : (b * 64 + (dir ? 63 - (s - 4) : (s - 4))); }

constexpr int G_LR = 0, G_SEG = 8192, G_CUM = 10240, G_TOT = 43008, G_T0 = 43520;
__device__ __forceinline__ void gla_decays(const Params& p, LAS unsigned char* L, int l, int cid, int h) {
    const int tid = tid_opaque();
    const bf16_t* Z = (const bf16_t*)(p.ws + WS_A);
    LAS float* LR = (LAS float*)(L + G_LR); LAS float* SEG = (LAS float*)(L + G_SEG); LAS float* CUM = (LAS float*)(L + G_CUM); LAS float* TOT = (LAS float*)(L + G_TOT);
    const int r0 = cid * 64;
    if (tid < 256) { const int t = tid >> 2, q = tid & 3; const u32x4 v = *(const u32x4*)(Z + (size_t)(r0 + t) * NIN + OFF_DEC + q * 8);
#pragma unroll
        for (int i = 0; i < 8; ++i) LR[t * 32 + q * 8 + i] = BFE(v, i); }
    __syncthreads();
    const int d = tid >> 8, k = tid & 63, tq = (tid >> 6) & 3;
    float w[16];
#pragma unroll
    for (int r = 0; r < 16; ++r) w[r] = p.in[I_WDEC][(((size_t)l * 2 + d) * 16 + r) * 256 + h * 64 + k];
    const float bias = p.in[I_BDEC][((size_t)l * 2 + d) * 256 + h * 64 + k];
    float la[16];
#pragma unroll
    for (int i = 0; i < 16; ++i) { const LAS float* lr = LR + (tq * 16 + i) * 32 + d * 16; float logit = bias;
#pragma unroll
        for (int r = 0; r < 16; ++r) logit += lr[r] * w[r];
        la[i] = (fminf(logit, 0.f) - __logf(1.f + __expf(-fabsf(logit)))) * (1.f / 16.f); }
    if (d == 0) {
#pragma unroll
        for (int i = 1; i < 16; ++i) la[i] += la[i - 1];
        SEG[(0 * 4 + tq) * 64 + k] = la[15];
    } else {
#pragma unroll
        for (int i = 14; i >= 0; --i) la[i] += la[i + 1];
        SEG[(1 * 4 + tq) * 64 + k] = la[0];
    }
    __syncthreads();
    float off = 0.f, tot = 0.f;
#pragma unroll
    for (int q = 0; q < 4; ++q) { const float sv = SEG[(d * 4 + q) * 64 + k]; tot += sv; if (d == 0 ? (q < tq) : (q > tq)) off += sv; }
#pragma unroll
    for (int i = 0; i < 16; ++i) CUM[(d * 64 + tq * 16 + i) * 64 + k] = la[i] + off;
    if (tq == 0) TOT[d * 64 + k] = tot;
    __syncthreads();
}

__device__ __forceinline__ void gla_vt(const bf16_t* Z, LAS bf16_t* VT, int r0, int h) {
    const int tid = tid_opaque(), t = tid >> 3, vq = tid & 7;
#pragma unroll
    for (int half = 0; half < 2; ++half) { const u32x4 v = *(const u32x4*)(Z + (size_t)(r0 + t) * NIN + OFF_V + h * 128 + vq * 16 + half * 8);
#pragma unroll
        for (int i = 0; i < 8; ++i) VT[(vq * 16 + half * 8 + i) * 72 + t] = (bf16_t)((i & 1) ? (v[i >> 1] >> 16) : (v[i >> 1] & 0xffffu)); }
}

__device__ __forceinline__ void gla_g1(const Params& p, LAS unsigned char* L, int l, int cid, int h) {
    const int tid = tid_opaque(), lane = tid & 63, wave = tid >> 6, r = lane & 31, hi = lane >> 5;
    const bf16_t* Z = (const bf16_t*)(p.ws + WS_A);
    gla_decays(p, L, l, cid, h);
    LAS float* CUM = (LAS float*)(L + G_CUM); LAS float* TOT = (LAS float*)(L + G_TOT);
    LAS bf16_t* KEF = (LAS bf16_t*)(L + G_T0); LAS bf16_t* KEB = (LAS bf16_t*)(L + G_T0 + 9216); LAS bf16_t* VT = (LAS bf16_t*)(L + G_T0 + 18432);
    const int r0 = cid * 64;
    { const int t = tid >> 3, kq = tid & 7; const u32x4 kv = *(const u32x4*)(Z + (size_t)(r0 + t) * NIN + OFF_K + h * 64 + kq * 8);
#pragma unroll
      for (int i = 0; i < 8; ++i) { const int k = kq * 8 + i; const float kval = BFE(kv, i);
          KEF[k * 72 + t] = (bf16_t)f2bf(kval * __expf(TOT[k] - CUM[t * 64 + k]));
          KEB[k * 72 + t] = (bf16_t)f2bf(kval * __expf(TOT[64 + k] - CUM[(64 + t) * 64 + k])); } }
    gla_vt(Z, VT, r0, h);
    __syncthreads();
    const int dvb = wave & 3, dkb = wave >> 2;
    f32x16 accf = ZERO16, accb = ZERO16;
    const LAS bf16_t* aF = KEF + (dkb * 32 + r) * 72 + 8 * hi; const LAS bf16_t* aB = KEB + (dkb * 32 + r) * 72 + 8 * hi; const LAS bf16_t* bV = VT + (dvb * 32 + r) * 72 + 8 * hi;
    mma64(accf, aF, bV); mma64(accb, aB, bV);
    bf16_t* US = (bf16_t*)(p.ws + WS_B);
    bf16_t* uf = US + ((size_t)((cid * 4 + h) * 2 + 0) * 128 + dvb * 32 + r) * 64 + dkb * 32 + 4 * hi;
    bf16_t* ub = US + ((size_t)((cid * 4 + h) * 2 + 1) * 128 + dvb * 32 + r) * 64 + dkb * 32 + 4 * hi;
#pragma unroll
    for (int g = 0; g < 4; ++g) { u32x2 o; o.x = pk2(accf[4 * g], accf[4 * g + 1]); o.y = pk2(accf[4 * g + 2], accf[4 * g + 3]); *(u32x2*)(uf + 8 * g) = o;
        o.x = pk2(accb[4 * g], accb[4 * g + 1]); o.y = pk2(accb[4 * g + 2], accb[4 * g + 3]); *(u32x2*)(ub + 8 * g) = o; }
    if (tid < 128) ((float*)(p.ws + WS_DEC))[(size_t)((cid * 4 + h) * 2 + (tid >> 6)) * 64 + (tid & 63)] = __expf(TOT[tid]);
    __syncthreads();
}

__device__ __forceinline__ void gla_g2(const Params& p, int item) {
    const int gid = item * NTHREADS + tid_opaque(), dk4 = gid & 15, dv = (gid >> 4) & 127, seq = gid >> 11, dir = seq & 1, h = (seq >> 1) & 3, b = seq >> 3;
    bf16_t* US = (bf16_t*)(p.ws + WS_B); const float* DEC = (const float*)(p.ws + WS_DEC);
    float s0 = 0.f, s1 = 0.f, s2 = 0.f, s3 = 0.f;
#pragma unroll 4
    for (int s = 0; s < 68; ++s) {
        const int cid = scan_cid(b, dir, s); const size_t tile = (size_t)((cid * 4 + h) * 2 + dir);
        u32x2* up = (u32x2*)(US + (tile * 128 + dv) * 64 + dk4 * 4);
        const u32x2 u = *up; const f32x4 d = *(const f32x4*)(DEC + tile * 64 + dk4 * 4);
        u32x2 o; o.x = pk2(s0, s1); o.y = pk2(s2, s3); *up = o;
        s0 = s0 * d.x + bflo(u.x); s1 = s1 * d.y + bfhi(u.x); s2 = s2 * d.z + bflo(u.y); s3 = s3 * d.w + bfhi(u.y);
    }
}

__device__ __forceinline__ void gla_g3(const Params& p, LAS unsigned char* L, int l, int cid, int h) {
    const int tid = tid_opaque(), lane = tid & 63, wave = tid >> 6, r = lane & 31, hi = lane >> 5;
    const bf16_t* Z = (const bf16_t*)(p.ws + WS_A);
    gla_decays(p, L, l, cid, h);
    LAS float* CUM = (LAS float*)(L + G_CUM);
    LAS bf16_t* QF = (LAS bf16_t*)(L + G_T0); LAS bf16_t* KF = (LAS bf16_t*)(L + G_T0 + 9216); LAS bf16_t* QB = (LAS bf16_t*)(L + G_T0 + 18432); LAS bf16_t* KB = (LAS bf16_t*)(L + G_T0 + 27648);
    LAS bf16_t* VT = (LAS bf16_t*)(L + G_T0 + 36864); LAS bf16_t* AF = (LAS bf16_t*)(L + G_T0 + 55296); LAS bf16_t* AB = (LAS bf16_t*)(L + G_T0 + 64512);
    LAS float* OST = (LAS float*)L;
    const int r0 = cid * 64;
    { const int t = tid >> 3, kq = tid & 7;
      const u32x4 qv = *(const u32x4*)(Z + (size_t)(r0 + t) * NIN + OFF_Q + h * 64 + kq * 8), kv = *(const u32x4*)(Z + (size_t)(r0 + t) * NIN + OFF_K + h * 64 + kq * 8);
      float qf[8], kf[8], qb[8], kb[8];
#pragma unroll
      for (int i = 0; i < 8; ++i) { const int k = kq * 8 + i; const float q = BFE(qv, i) * 0.125f, kk = BFE(kv, i), bw = CUM[t * 64 + k], cw = CUM[(64 + t) * 64 + k];
          qf[i] = q * __expf(bw); kf[i] = kk * __expf(-bw); qb[i] = q * __expf(cw); kb[i] = kk * __expf(-cw); }
      u32x4 o;
      o.x = pk2(qf[0], qf[1]); o.y = pk2(qf[2], qf[3]); o.z = pk2(qf[4], qf[5]); o.w = pk2(qf[6], qf[7]); *(LAS u32x4*)(QF + t * 72 + kq * 8) = o;
      o.x = pk2(kf[0], kf[1]); o.y = pk2(kf[2], kf[3]); o.z = pk2(kf[4], kf[5]); o.w = pk2(kf[6], kf[7]); *(LAS u32x4*)(KF + t * 72 + kq * 8) = o;
      o.x = pk2(qb[0], qb[1]); o.y = pk2(qb[2], qb[3]); o.z = pk2(qb[4], qb[5]); o.w = pk2(qb[6], qb[7]); *(LAS u32x4*)(QB + t * 72 + kq * 8) = o;
      o.x = pk2(kb[0], kb[1]); o.y = pk2(kb[2], kb[3]); o.z = pk2(kb[4], kb[5]); o.w = pk2(kb[6], kb[7]); *(LAS u32x4*)(KB + t * 72 + kq * 8) = o; }
    gla_vt(Z, VT, r0, h);
    __syncthreads();
    {
      const int bw = wave >> 2, ib = wave & 1, jb = (wave >> 1) & 1;
      f32x16 acc = ZERO16;
      const bool live = bw ? (jb >= ib) : (jb <= ib);
      if (live) { if (bw) mma64(acc, QB + (ib * 32 + r) * 72 + 8 * hi, KB + (jb * 32 + r) * 72 + 8 * hi); else mma64(acc, QF + (ib * 32 + r) * 72 + 8 * hi, KF + (jb * 32 + r) * 72 + 8 * hi); }
      LAS bf16_t* AT = bw ? AB : AF; const int j = jb * 32 + r;
#pragma unroll
      for (int reg = 0; reg < 16; ++reg) { const int i = ib * 32 + ACC_ROW(reg, hi); const bool keep = bw ? (j >= i) : (j <= i); AT[i * 72 + j] = (bf16_t)f2bf(keep ? acc[reg] : 0.f); } }
    __syncthreads();
    const int tb = wave & 1, dvb = wave >> 1;
    f32x16 acc = ZERO16;
    { const LAS bf16_t* bV = VT + (dvb * 32 + r) * 72 + 8 * hi;
      mma64(acc, AF + (tb * 32 + r) * 72 + 8 * hi, bV); mma64(acc, AB + (tb * 32 + r) * 72 + 8 * hi, bV);
      const bf16_t* US = (const bf16_t*)(p.ws + WS_B);
      const bf16_t* sF = US + ((size_t)((cid * 4 + h) * 2 + 0) * 128 + dvb * 32 + r) * 64 + 8 * hi; const bf16_t* sB = US + ((size_t)((cid * 4 + h) * 2 + 1) * 128 + dvb * 32 + r) * 64 + 8 * hi;
      mma64(acc, QF + (tb * 32 + r) * 72 + 8 * hi, sF); mma64(acc, QB + (tb * 32 + r) * 72 + 8 * hi, sB); }
#pragma unroll
    for (int reg = 0; reg < 16; ++reg) OST[(tb * 32 + ACC_ROW(reg, hi)) * 132 + dvb * 32 + r] = acc[reg];
    __syncthreads();
    { const int t = tid >> 3, part = tid & 7; float o[16]; float ss = 0.f;
#pragma unroll
      for (int i = 0; i < 16; ++i) { o[i] = OST[t * 132 + part * 16 + i]; ss += o[i] * o[i]; }
      ss += __shfl_xor(ss, 1); ss += __shfl_xor(ss, 2); ss += __shfl_xor(ss, 4);
      const float rstd = rsqrtf(ss * (1.f / 128.f) + EPS);
      const float* gg = p.in[I_GGLA] + l * 128 + part * 16;
      bf16_t* Y = (bf16_t*)(p.ws + WS_HY) + (size_t)(r0 + t) * D + h * 128 + part * 16;
#pragma unroll
      for (int half = 0; half < 2; ++half) { const u32x4 og = *(const u32x4*)(Z + (size_t)(r0 + t) * NIN + OFF_OG + h * 128 + part * 16 + half * 8); float y[8];
#pragma unroll
          for (int i = 0; i < 8; ++i) { const float z = BFE(og, i); y[i] = o[half * 8 + i] * rstd * gg[half * 8 + i] * (z * __builtin_amdgcn_rcpf(1.f + __expf(-z))); }
          u32x4 w; w.x = pk2(y[0], y[1]); w.y = pk2(y[2], y[3]); w.z = pk2(y[4], y[5]); w.w = pk2(y[6], y[7]); *(u32x4*)(Y + half * 8) = w; } }
    __syncthreads();
}

constexpr int R_UB = 0, R_UF = 9216, R_AA = 25600, R_BX = 58368;
template <bool FINAL>
__device__ __forceinline__ void rg_item(const Params& p, LAS unsigned char* L, int l, int cid, int head) {
    const int tid = tid_opaque(), lane = tid & 63, wave = tid >> 6, r = lane & 31, hi = lane >> 5;
    const bf16_t* Z = (const bf16_t*)(p.ws + WS_A);
    LAS bf16_t* UB = (LAS bf16_t*)(L + R_UB); LAS float* UF = (LAS float*)(L + R_UF); LAS float* AA = (LAS float*)(L + R_AA); LAS float* BX = (LAS float*)(L + R_BX);
    const int r0 = cid * 64;
    { const int t = tid >> 3, cq = tid & 7, ch0 = head * 64 + cq * 8;
      int pos, len, lbase;
      if (cid < 512) { pos = t; len = 64; lbase = r0; } else { const int n = (cid - 512) & 3; pos = n * 64 + t; len = 256; lbase = r0 - n * 64; }
      float u[8];
#pragma unroll
      for (int i = 0; i < 8; ++i) u[i] = p.in[I_BCONV][l * 256 + ch0 + i];
#pragma unroll
      for (int j = 0; j < 4; ++j) { const int pp = pos + j - 1;
          if (pp >= 0 && pp < len) { const u32x4 zv = *(const u32x4*)(Z + (size_t)(lbase + pp) * NIN + OFF_RX + ch0); const float* wc = p.in[I_WCONV] + ((size_t)l * 4 + j) * 256 + ch0;
#pragma unroll
              for (int i = 0; i < 8; ++i) u[i] += wc[i] * BFE(zv, i); } }
      u32x4 o; o.x = pk2(u[0], u[1]); o.y = pk2(u[2], u[3]); o.z = pk2(u[4], u[5]); o.w = pk2(u[6], u[7]); *(LAS u32x4*)(UB + t * 72 + cq * 8) = o;
      *(LAS f32x4*)(UF + t * 64 + cq * 8) = (f32x4){u[0], u[1], u[2], u[3]}; *(LAS f32x4*)(UF + t * 64 + cq * 8 + 4) = (f32x4){u[4], u[5], u[6], u[7]}; }
    __syncthreads();
    { const int tb = wave & 1, ob = (wave >> 1) & 1, dir = wave >> 2;
      const bf16_t* WRG = (const bf16_t*)(p.ws + WS_WRG);
      const bf16_t* bA = WRG + ((((size_t)(l * 2 + dir) * 2 + 0) * 4 + head) * 64 + ob * 32 + r) * 64 + 8 * hi;
      const bf16_t* bXw = WRG + ((((size_t)(l * 2 + dir) * 2 + 1) * 4 + head) * 64 + ob * 32 + r) * 64 + 8 * hi;
      const LAS bf16_t* aU = UB + (tb * 32 + r) * 72 + 8 * hi;
      f32x16 accA = ZERO16, accX = ZERO16; mma64(accA, aU, bA); mma64(accX, aU, bXw);
      const int ch = ob * 32 + r, gch = head * 64 + ch;
      const float ba = p.in[I_BRGA][(l * 2 + dir) * 256 + gch], bx_ = p.in[I_BRGX][(l * 2 + dir) * 256 + gch], lam = p.in[I_RGLAM][(l * 2 + dir) * 256 + gch];
      const float sp = fmaxf(-lam, 0.f) + log1pf(__expf(-fabsf(lam)));
#pragma unroll
      for (int reg = 0; reg < 16; ++reg) { const int tt = tb * 32 + ACC_ROW(reg, hi);
          const float rr = sigmoidf_(accA[reg] + ba), ii = sigmoidf_(accX[reg] + bx_), loga = -8.f * rr * sp, a = __expf(loga), x2 = 2.f * loga;
          const float om = (x2 > -0.25f) ? -x2 * (1.f + 0.5f * x2 * (1.f + (1.f / 3.f) * x2 * (1.f + 0.25f * x2 * (1.f + 0.2f * x2)))) : 1.f - __expf(x2), mult = __builtin_amdgcn_sqrtf(om);
          AA[(dir * 64 + tt) * 64 + ch] = a; BX[(dir * 64 + tt) * 64 + ch] = mult * ii * UF[tt * 64 + ch]; } }
    __syncthreads();
    if (tid < 128) { const int dir = tid >> 6, ch = tid & 63;
        if (!FINAL) { float hh = 0.f, P = 1.f;
#pragma unroll 4
            for (int s = 0; s < 64; ++s) { const int t = dir ? 63 - s : s; const float a = AA[(dir * 64 + t) * 64 + ch]; hh = a * hh + BX[(dir * 64 + t) * 64 + ch]; P *= a; }
            float* RGS = (float*)(p.ws + WS_RGS) + (size_t)(((cid * 4 + head) * 2 + dir) * 2) * 64 + ch; RGS[0] = P; RGS[64] = hh;
        } else { float hh = ((const float*)(p.ws + WS_HST))[(size_t)(cid * 2 + dir) * 256 + head * 64 + ch];
#pragma unroll 4
            for (int s = 0; s < 64; ++s) { const int t = dir ? 63 - s : s; hh = AA[(dir * 64 + t) * 64 + ch] * hh + BX[(dir * 64 + t) * 64 + ch]; BX[(dir * 64 + t) * 64 + ch] = hh; } } }
    __syncthreads();
    if (FINAL) { const int t = tid >> 3, cq = tid & 7;
        const u32x4 zg = *(const u32x4*)(Z + (size_t)(r0 + t) * NIN + OFF_RG + head * 64 + cq * 8); float y[8];
#pragma unroll
        for (int i = 0; i < 8; ++i) { const float hs = BX[t * 64 + cq * 8 + i] + BX[(64 + t) * 64 + cq * 8 + i], z = BFE(zg, i);
            const float yy = 0.7978845608028654f * (z + 0.044715f * z * z * z), ge = z * (1.f - __builtin_amdgcn_rcpf(1.f + __expf(2.f * yy))); y[i] = hs * ge; }
        u32x4 w; w.x = pk2(y[0], y[1]); w.y = pk2(y[2], y[3]); w.z = pk2(y[4], y[5]); w.w = pk2(y[6], y[7]);
        *(u32x4*)((bf16_t*)(p.ws + WS_HY) + (size_t)(r0 + t) * D + 768 + head * 64 + cq * 8) = w;
        __syncthreads(); }
}
__device__ __forceinline__ void rg_r2(const Params& p, int item) {
    const int gid = item * NTHREADS + tid_opaque(), ch = gid & 255, dir = (gid >> 8) & 1, b = gid >> 9, head = ch >> 6, c = ch & 63;
    const float* RGS = (const float*)(p.ws + WS_RGS); float* HST = (float*)(p.ws + WS_HST);
    float hh = 0.f;
#pragma unroll 4
    for (int s = 0; s < 68; ++s) { const int cid = scan_cid(b, dir, s); const float* q = RGS + (size_t)(((cid * 4 + head) * 2 + dir) * 2) * 64 + c;
        HST[(size_t)(cid * 2 + dir) * 256 + ch] = hh; hh = q[0] * hh + q[64]; }
}

__device__ __forceinline__ void fourier_tables(LAS unsigned char* L) {
    LAS bf16_t* CM = (LAS bf16_t*)(L + TAB_OFF); LAS bf16_t* SM = (LAS bf16_t*)(L + TAB_OFF + 9216); LAS float* COST = (LAS float*)(L + TAB_OFF + 18432);
    for (int i = tid_opaque(); i < 4096; i += NTHREADS) { COST[i] = cospif((float)i * (1.f / 2048.f)); const int rr = i >> 6, c = i & 63; const float a = (float)((rr * c) & 63) * (1.f / 32.f);
        CM[rr * 72 + c] = (bf16_t)f2bf(cospif(a)); SM[rr * 72 + c] = (bf16_t)f2bf(sinpif(a)); }
    __syncthreads();
}
__device__ __forceinline__ void fourier_f1(const Params& p, LAS unsigned char* L, int b, int g, int tab) {
    const int tid = tid_opaque(), lane = tid & 63, wave = tid >> 6, r = lane & 31, hi = lane >> 5;
    const bf16_t* Z = (const bf16_t*)(p.ws + WS_A); bf16_t* FZ = (bf16_t*)(p.ws + WS_FZ);
    const LAS bf16_t* CM = (const LAS bf16_t*)(L + TAB_OFF); const LAS bf16_t* SM = (const LAS bf16_t*)(L + TAB_OFF + 9216); const LAS float* COST = (const LAS float*)(L + TAB_OFF + 18432);
    const int set = wave >> 2, wl = wave & 3;
    LAS bf16_t* X = (LAS bf16_t*)(L + set * 27648); LAS bf16_t* AT = X + 4608; LAS bf16_t* BT = X + 9216;
    for (int it = 0; it < 4; ++it) {
#pragma unroll
        for (int s = 0; s < 2; ++s) { const int ta = tab * 8 + it * 2 + s, tb = tid >> 3, cq = tid & 7;
            *(LAS u32x4*)((LAS bf16_t*)(L + s * 27648) + tb * 72 + cq * 8) = *(const u32x4*)(Z + (size_t)(b * 4096 + 64 * tb + ta) * NIN + OFF_F + g * 64 + cq * 8); }
        __syncthreads();
        { const int tbb = wl & 1, mb = wl >> 1; f32x16 aC = ZERO16, aS = ZERO16;
          const LAS bf16_t* aX = X + (tbb * 32 + r) * 72 + 8 * hi;
          mma64(aC, aX, CM + (mb * 32 + r) * 72 + 8 * hi); mma64(aS, aX, SM + (mb * 32 + r) * 72 + 8 * hi);
          const int m = mb * 32 + r;
#pragma unroll
          for (int q = 0; q < 4; ++q) { u32x2 o; o.x = pk2(aC[4 * q], aC[4 * q + 1]); o.y = pk2(aC[4 * q + 2], aC[4 * q + 3]); *(LAS u32x2*)(AT + m * 72 + tbb * 32 + 8 * q + 4 * hi) = o;
              o.x = pk2(-aS[4 * q], -aS[4 * q + 1]); o.y = pk2(-aS[4 * q + 2], -aS[4 * q + 3]); *(LAS u32x2*)(BT + m * 72 + tbb * 32 + 8 * q + 4 * hi) = o; } }
        __syncthreads();
        { const int kab = wl & 1, mb = wl >> 1; f32x16 zr = ZERO16, z1 = ZERO16, z2 = ZERO16;
          const LAS bf16_t* aC = CM + (kab * 32 + r) * 72 + 8 * hi; const LAS bf16_t* aS = SM + (kab * 32 + r) * 72 + 8 * hi;
          const LAS bf16_t* bA = AT + (mb * 32 + r) * 72 + 8 * hi; const LAS bf16_t* bB = BT + (mb * 32 + r) * 72 + 8 * hi;
          mma64(zr, aC, bA); mma64(zr, aS, bB); mma64(z1, aC, bB); mma64(z2, aS, bA);
          const int ta = tab * 8 + it * 2 + set, m = mb * 32 + r;
#pragma unroll
          for (int reg = 0; reg < 16; ++reg) { const int ka = kab * 32 + ACC_ROW(reg, hi), idx = (ta * ka) & 4095; const float cs = COST[idx], sn = COST[(idx + 3072) & 4095];
              const float re = zr[reg], im = z1[reg] - z2[reg];
              bf16_t* o = FZ + ((((size_t)(b * 4 + g) * 64 + ta) * 64 + ka) * 2) * 64 + m;
              o[0] = (bf16_t)f2bf(re * cs + im * sn); o[64] = (bf16_t)f2bf(im * cs - re * sn); } }
    }
    __syncthreads();
}
__device__ __forceinline__ void fourier_f2(const Params& p, LAS unsigned char* L, int b, int g, int kap) {
    const int tid = tid_opaque(), lane = tid & 63, wave = tid >> 6, r = lane & 31, hi = lane >> 5;
    const bf16_t* FZ = (const bf16_t*)(p.ws + WS_FZ);
    const LAS bf16_t* CM = (const LAS bf16_t*)(L + TAB_OFF); const LAS bf16_t* SM = (const LAS bf16_t*)(L + TAB_OFF + 9216);
#pragma unroll
    for (int j = 0; j < 4; ++j) { const int piece = tid + NTHREADS * j, set = piece >> 10, pp = piece & 1023, ta = pp >> 4, ri = (pp >> 3) & 1, mq = pp & 7, ka = kap * 2 + set;
        const u32x4 v = *(const u32x4*)(FZ + ((((size_t)(b * 4 + g) * 64 + ta) * 64 + ka) * 2 + ri) * 64 + mq * 8);
        LAS bf16_t* ZT = (LAS bf16_t*)(L + set * 18432 + ri * 9216);
#pragma unroll
        for (int i = 0; i < 8; ++i) ZT[(mq * 8 + i) * 72 + ta] = (bf16_t)((i & 1) ? (v[i >> 1] >> 16) : (v[i >> 1] & 0xffffu)); }
    __syncthreads();
    { const int set = wave >> 2, wl = wave & 3, kbb = wl & 1, mb = wl >> 1, ka = kap * 2 + set;
      const LAS bf16_t* ZR = (const LAS bf16_t*)(L + set * 18432); const LAS bf16_t* ZI = ZR + 4608;
      f32x16 acc = ZERO16;
      mma64(acc, CM + (kbb * 32 + r) * 72 + 8 * hi, ZR + (mb * 32 + r) * 72 + 8 * hi); mma64(acc, SM + (kbb * 32 + r) * 72 + 8 * hi, ZI + (mb * 32 + r) * 72 + 8 * hi);
      bf16_t* Y = (bf16_t*)(p.ws + WS_HY);
#pragma unroll
      for (int reg = 0; reg < 16; ++reg) { const int kb = kbb * 32 + ACC_ROW(reg, hi); Y[(size_t)(b * 4096 + ka + 64 * kb) * D + 512 + g * 64 + mb * 32 + r] = (bf16_t)f2bf(acc[reg] * (1.f / 512.f)); } }
    __syncthreads();
}
__device__ __forceinline__ void fourier_ctx(const Params& p, LAS unsigned char* L, int b, int g, int mq) {
    const int tid = tid_opaque();
    const bf16_t* Z = (const bf16_t*)(p.ws + WS_A);
    LAS bf16_t* XC = (LAS bf16_t*)L; LAS float* AC = (LAS float*)(L + 32768); LAS float* BC = (LAS float*)(L + 49152); const LAS float* COST = (const LAS float*)(L + TAB_OFF + 18432);
#pragma unroll
    for (int j = 0; j < 4; ++j) { const int piece = tid + NTHREADS * j, t = piece >> 3, cq = piece & 7;
        *(LAS u32x4*)(XC + t * 64 + cq * 8) = *(const u32x4*)(Z + (size_t)(NLAT + b * 256 + t) * NIN + OFF_F + g * 64 + cq * 8); }
    __syncthreads();
    const int mi = tid & 15, m = mq * 16 + mi, t0 = tid >> 4;
    for (int j = 0; j < 8; ++j) { const int t = t0 + 32 * j; float a = 0.f, bi = 0.f;
        for (int c = 0; c < 64; ++c) { const float x = bf1(XC[t * 64 + c]); const int idx = ((m * c) & 63) * 64; a += x * COST[idx]; bi -= x * COST[(idx + 3072) & 4095]; }
        AC[t * 16 + mi] = a; BC[t * 16 + mi] = bi; }
    __syncthreads();
    float acc[8];
#pragma unroll
    for (int j = 0; j < 8; ++j) acc[j] = 0.f;
    for (int t = 0; t < 256; ++t) { const float a = AC[t * 16 + mi], bi = BC[t * 16 + mi];
#pragma unroll
        for (int j = 0; j < 8; ++j) { const int k = t0 + 32 * j, idx = ((k * t) & 255) * 16; acc[j] += COST[idx] * a + COST[(idx + 3072) & 4095] * bi; } }
    bf16_t* Y = (bf16_t*)(p.ws + WS_HY);
#pragma unroll
    for (int j = 0; j < 8; ++j) { const int k = t0 + 32 * j; Y[(size_t)(NLAT + b * 256 + k) * D + 512 + g * 64 + m] = (bf16_t)f2bf(acc[j] * (1.f / 128.f)); }
    __syncthreads();
}

#define RLX_AGENT __ATOMIC_RELAXED, __HIP_MEMORY_SCOPE_AGENT
#define XB_TMO      128
#define XB_XCNT(j)  (256  + 64 * (j))
#define XB_XSUB(j)  (1280 + 64 * (j))
#define XB_XGEN(j)  (2304 + 64 * (j))
#define XB_TOP      3328
#define XB_TOPGEN   3392
#define XCD_BAR_WORDS 3456
#define XB_SPIN_CAP (1u << 18)

__device__ __forceinline__ unsigned xb_ld(unsigned* p)              { return __hip_atomic_load(p, __ATOMIC_RELAXED, __HIP_MEMORY_SCOPE_AGENT); }
__device__ __forceinline__ unsigned xb_add(unsigned* p, unsigned v) { return __hip_atomic_fetch_add(p, v, __ATOMIC_RELAXED, __HIP_MEMORY_SCOPE_AGENT); }
__device__ __forceinline__ unsigned xb_xcc_id() { return (unsigned)__builtin_amdgcn_s_getreg((3 << 11) | 20) & 0xFu; }
#define XB_SPIN(cond, bar) do { unsigned _sp = 0; while (cond) { __builtin_amdgcn_s_sleep(1); \
    if ((++_sp & 255u) == 0u) { if (xb_ld(&(bar)[XB_TMO])) break; if (_sp > XB_SPIN_CAP) { atomicAdd(&(bar)[XB_TMO], 1u); break; } } } } while (0)

struct XcdBarrier {
    unsigned* bar; unsigned x;
    volatile LAS unsigned* st;
};

__device__ __forceinline__ XcdBarrier xcd_barrier_post(unsigned* bar, volatile LAS unsigned* st) {
    XcdBarrier b; b.bar = bar; b.x = xb_xcc_id(); b.st = st;
    if (threadIdx.x == 0) (void)xb_add(&bar[XB_XCNT(b.x)], 1u);
    return b;
}
__device__ __forceinline__ void xcd_barrier_complete(unsigned* bar, unsigned x, unsigned& nloc, unsigned& nx) {
    const unsigned G = gridDim.x * gridDim.y * gridDim.z;
    unsigned sum, cnt, mine, sp = 0u;
    for (;;) {
        sum = 0u; cnt = 0u; mine = 0u;
#pragma unroll
        for (unsigned j = 0; j < 16; ++j) { const unsigned c = xb_ld(&bar[XB_XCNT(j)]); sum += c; cnt += (c > 0u) ? 1u : 0u; mine = (j == x) ? c : mine; }
        if (sum == G) break;
        __builtin_amdgcn_s_sleep(1);
        if ((++sp & 255u) == 0u) { if (xb_ld(&bar[XB_TMO])) break; if (sp > XB_SPIN_CAP) { atomicAdd(&bar[XB_TMO], 1u); break; } }
    }
    nloc = mine > 0u ? mine : 1u; nx = cnt > 0u ? cnt : 1u;
}

__device__ __forceinline__ void xcd_barrier(const XcdBarrier& b) {
    asm volatile("s_waitcnt vmcnt(0)" ::: "memory");
    __syncthreads();
    if (threadIdx.x == 0) {
        unsigned* bar = b.bar;
        __builtin_amdgcn_s_waitcnt(0);
        unsigned nloc = b.st[0], nx = b.st[1];
        if (nloc == 0u) { xcd_barrier_complete(bar, b.x, nloc, nx); b.st[0] = nloc; b.st[1] = nx; }
        const unsigned old = xb_add(&bar[XB_XSUB(b.x)], 1u);
        const unsigned gen = old / nloc;
        if (old + 1u == (gen + 1u) * nloc) {
            __builtin_amdgcn_fence(__ATOMIC_RELEASE, "agent");
            asm volatile("s_waitcnt vmcnt(0)" ::: "memory");
            const unsigned og = xb_add(&bar[XB_TOP], 1u);
            const unsigned tg = og / nx;
            if (og + 1u == (tg + 1u) * nx) xb_add(&bar[XB_TOPGEN], 1u);
            else XB_SPIN(xb_ld(&bar[XB_TOPGEN]) == tg, bar);
            __builtin_amdgcn_fence(__ATOMIC_ACQUIRE, "agent");
            xb_add(&bar[XB_XGEN(b.x)], 1u);
            asm volatile("s_waitcnt vmcnt(0)" ::: "memory");
        } else {
            XB_SPIN(xb_ld(&bar[XB_XGEN(b.x)]) == gen, bar);
            __builtin_amdgcn_fence(__ATOMIC_ACQUIRE, "agent");
            asm volatile("s_waitcnt vmcnt(0)" ::: "memory");
        }
    }
    __syncthreads();
}
constexpr int NPHASES = 2 + 9 * DEPTH;
#ifndef PROBE_DUP
#define PROBE_DUP 0
#endif
__global__ void __launch_bounds__(NTHREADS, 2) mega_fwd(Params p) {
    extern __shared__ __attribute__((aligned(16))) unsigned char lds_raw[];
    LAS unsigned char* L = (LAS unsigned char*)lds_raw;
    cg::grid_group grid = cg::this_grid();
    if (threadIdx.x < 64) ((volatile LAS unsigned*)(L + MISC_OFF))[threadIdx.x] = 0u;
    __syncthreads();
    XcdBarrier xbar = xcd_barrier_post((unsigned*)(p.ws + WS_CTL), (volatile LAS unsigned*)(L + MISC_OFF));
    unsigned char* ws = p.ws;
    const float* MOD = (const float*)(ws + WS_MOD);
    const int G = gridDim.x, bx = blockIdx.x;
    for (int ph = p.ph_lo; ph < p.ph_hi; ++ph) {
        if (ph == 0) { phase_prologue(p, L); if (PROBE_DUP & 64) { __syncthreads(); phase_prologue(p, L); } }
        else if (ph != 1) {
            const int l = (ph - 2) / 9, sub = (ph - 2) % 9; const bool last = (l == DEPTH - 1);
            const int mrows = last ? NLAT : MROWS, nchunk = last ? 512 : NCHUNK;
            const float* modl = MOD + (size_t)l * 9 * 6144;
            const float* xlat = (l == 0) ? p.in[I_X] : p.out; const float* xctx = (l == 0) ? p.in[I_CTX] : (const float*)(ws + WS_XC);
            const int dupbit = (sub == 0) ? 1 : (sub == 4) ? 2 : (sub == 6) ? 4 : (sub == 7) ? 8 : (sub == 1) ? 16 : (sub == 3) ? 32 : 0;
            for (int rep = 0; rep < ((PROBE_DUP & dupbit) ? 2 : 1); ++rep)
            switch (sub) {
            case 0: { pg8::Gemm g{(const bf16_t*)(ws + WS_HY), (const bf16_t*)(ws + WS_WIN) + (size_t)l * NINP * D, MROWS, NINP, D}; pg8::StaticOrder S; S.init(MROWS, NINP, G, bx);
                      pg8::EpiBf16N E{(bf16_t*)(ws + WS_A), NIN, NIN}; pg8::gemm_phase<pg8::EpiBf16N, pg8::StaticOrder, true, true>(L, g, S, E); } break;
            case 1: { fourier_tables(L);
                      for (int j = bx; j < 256; j += G) fourier_f1(p, L, j >> 5, (j >> 3) & 3, j & 7);
                      if (!last) for (int j = (bx + 128) % G; j < 128; j += G) fourier_ctx(p, L, j >> 4, (j >> 2) & 3, j & 3);
                      for (int j = bx; j < NCHUNK * 4; j += G) gla_g1(p, L, l, j >> 2, j & 3);
                      for (int j = (bx + 128) % G; j < NCHUNK * 4; j += G) rg_item<false>(p, L, l, j >> 2, j & 3); } break;
            case 2: { fourier_tables(L);
                      for (int j = bx; j < 256; j += G) gla_g2(p, j);
                      for (int j = bx; j < 8; j += G) rg_r2(p, j);
                      for (int j = bx; j < 1024; j += G) fourier_f2(p, L, j >> 7, (j >> 5) & 3, j & 31); } break;
            case 3: { const int nG = nchunk * 4;
                      for (int j = bx; j < nG; j += G) gla_g3(p, L, l, j >> 2, j & 3);
                      for (int j = (bx + 128) % G; j < nG; j += G) rg_item<true>(p, L, l, j >> 2, j & 3); } break;
            case 4: { pg8::Gemm g{(const bf16_t*)(ws + WS_HY), (const bf16_t*)(ws + WS_WOUT) + (size_t)l * D * D, mrows, D, D}; pg8::StaticOrder S; S.init(mrows, D, G, bx);
                      pg8::EpiF32 E{(float*)(ws + WS_B), D}; pg8::gemm_phase<pg8::EpiF32, pg8::StaticOrder, true, true>(L, g, S, E); } break;
            case 5: break;
            case 6: { pg8::Gemm g{(const bf16_t*)(ws + WS_HY), (const bf16_t*)(ws + WS_WGU) + (size_t)l * 2 * DFF * D, mrows, 2 * DFF, D}; pg8::StaticOrder S; S.init(mrows, 2 * DFF, G, bx);
                      pg8::EpiSwiGLU E{(bf16_t*)(ws + WS_A), DFF}; pg8::gemm_phase<pg8::EpiSwiGLU, pg8::StaticOrder, true, true>(L, g, S, E); } break;
            case 7: { pg8::Gemm g{(const bf16_t*)(ws + WS_A), (const bf16_t*)(ws + WS_WDN) + (size_t)l * D * DFF, mrows, D, DFF}; pg8::StaticOrder S; S.init(mrows, D, G, bx);
                      pg8::EpiF32 E{(float*)(ws + WS_B), D}; pg8::gemm_phase<pg8::EpiF32, pg8::StaticOrder, true, true>(L, g, S, E); } break;
            default: break;
            }
        }
        {
            const int l = (ph < 2) ? 0 : (ph - 2) / 9, sub = (ph < 2) ? -1 : (ph - 2) % 9; const bool last = (l == DEPTH - 1);
            if (ph == 1 || sub == 5 || sub == 8) {
                const bool has_t = (ph != 1), r2 = (sub == 8);
                const float* modl = MOD + (size_t)l * 9 * 6144;
                const float* xlat = (l == 0 && !r2) ? p.in[I_X] : p.out; const float* xctx = (l == 0 && !r2) ? p.in[I_CTX] : (const float*)(ws + WS_XC);
                const int lh = r2 ? (last ? l : l + 1) : l;
                rows_phase(p, has_t, (last && has_t) ? NLAT : MROWS, xlat, xctx, (const float*)(ws + WS_B), p.in[r2 ? I_GPOSTFFN : I_GPOSTMIX] + l * D, modl, r2 ? 5120 : 2048,
                           !(r2 && last), p.in[(sub == 5) ? I_GPREFFN : I_GPREMIX] + lh * D, MOD + (size_t)lh * 9 * 6144, (sub == 5) ? 3072 : 0, (sub == 5) ? 4096 : 1024);
            }
        }
        if (ph + 1 < p.ph_hi) { if (ph == 0) grid.sync(); else xcd_barrier(xbar); }
    }
}

#ifndef MK_SPLIT
#define MK_SPLIT 0
#endif
extern "C" void kernel_launch(void* const* d_in, const int* in_sizes, int n_in, void* d_out, int out_size, void* d_ws, size_t ws_size, hipStream_t stream) {
    static int grid = 0;
    if (grid == 0) {
        int dev = 0, cus = 0, per_cu = 0;
        if (n_in != 25 || ws_size < WS_CTL + CTL_BYTES) { fprintf(stderr, "kernel_launch: unexpected inputs (n_in %d, ws %zu)\n", n_in, ws_size); grid = -1; return; }
        hipGetDevice(&dev); hipDeviceGetAttribute(&cus, hipDeviceAttributeMultiprocessorCount, dev);
        if (hipFuncSetAttribute((const void*)mega_fwd, hipFuncAttributeMaxDynamicSharedMemorySize, LDS_BYTES) != hipSuccess) fprintf(stderr, "kernel_launch: hipFuncSetAttribute failed\n");
        if (hipOccupancyMaxActiveBlocksPerMultiprocessor(&per_cu, (const void*)mega_fwd, NTHREADS, LDS_BYTES) != hipSuccess || per_cu < 1) { fprintf(stderr, "kernel_launch: occupancy query gave %d\n", per_cu); per_cu = 1; }
        (void)hipGetLastError();
        grid = cus * 1;
    }
    if (grid < 0) return;
    if (hipMemsetAsync((char*)d_ws + WS_CTL, 0, CTL_BYTES, stream) != hipSuccess) fprintf(stderr, "kernel_launch: memset failed\n");
    Params p{};
    for (int i = 0; i < 25; ++i) p.in[i] = (const float*)d_in[i];
    p.out = (float*)d_out; p.ws = (unsigned char*)d_ws;
#if MK_SPLIT
    for (int ph = 0; ph < NPHASES; ++ph) { p.ph_lo = ph; p.ph_hi = ph + 1; hipLaunchKernelGGL(mega_fwd, dim3(grid), dim3(NTHREADS), LDS_BYTES, stream, p); }
#else
    p.ph_lo = 0; p.ph_hi = NPHASES;
    void* args[] = {&p};
    hipError_t e = hipLaunchCooperativeKernel((const void*)mega_fwd, dim3(grid), dim3(NTHREADS), args, LDS_BYTES, stream);
    if (e != hipSuccess) fprintf(stderr, "kernel_launch: cooperative launch failed: %s (grid %d)\n", hipGetErrorString(e), grid);
#endif
}
```

```cpp
#include <hip/hip_runtime.h>
#include <hip/hip_cooperative_groups.h>
#include <cstdio>
#include <cstdint>
namespace cg = cooperative_groups;
namespace pg8 {
#define PG8_LAS __attribute__((address_space(3)))
typedef unsigned short bf16_t;
typedef short bf16x8 __attribute__((ext_vector_type(8)));
typedef float f32x4 __attribute__((ext_vector_type(4)));
typedef unsigned u32x4 __attribute__((ext_vector_type(4)));
constexpr int BM = 256, BK = 64, HALF = 128, HTB = HALF * BK * 2  , STAGE_BYTES = 8 * HTB, NXCD = 8, WGM = 8;

__host__ __device__ __forceinline__ int lds_byte(int r, int c) { const int st = (r >> 4) * 2 + (c >> 5), rr = r & 15, cc = c & 31, ob = rr * 64 + cc * 2; return st * 1024 + (ob ^ (((ob >> 9) & 1) << 5)); }
__host__ __device__ __forceinline__ void stage_rc(int b, int& R, int& C) { const int st = b / 1024, sb = b % 1024, swz = sb ^ (((sb >> 9) & 1) << 5); R = (st >> 1) * 16 + swz / 64; C = (st & 1) * 32 + (swz % 64) / 2; }
__host__ __device__ __forceinline__ int perm32(int rho) { const int n = rho >> 4, i = rho & 15; return 8 * (i >> 2) + 4 * n + (i & 3); }

struct Unit { int pm, pn; };
struct Gemm { const bf16_t* A; const bf16_t* Bt; int M, N, K; };

struct StaticOrder {
    int nM, nN, nwg, G, c;
    __host__ __device__ void init(int M, int N, int G_, int c_) { nM = M / BM; nN = N / BM; nwg = nM * nN; G = G_; c = c_; }
    __host__ __device__ bool next(int i, Unit& u) const {
        const long L = (long)i * G + c; if (L >= nwg) return false;
        int wgid = (int)L; { const int q = nwg / NXCD, r = nwg % NXCD, xcd = wgid % NXCD, off = wgid / NXCD; wgid = (xcd < r ? xcd * (q + 1) : r * (q + 1) + (xcd - r) * q) + off; }
        const int nig = WGM * nN, gid = wgid / nig, fm = gid * WGM, gsz = (nM - fm) < WGM ? (nM - fm) : WGM;
        u.pm = fm + ((wgid % nig) % gsz); u.pn = (wgid % nig) / gsz; return true;
    }
    __device__ __forceinline__ void a_ready(const Unit&) const {}
    __device__ __forceinline__ void done(const Unit&) const {}
};

__device__ __forceinline__ unsigned cvt_pk_bf16(float lo, float hi) { unsigned r; asm volatile("v_cvt_pk_bf16_f32 %0, %1, %2" : "=v"(r) : "v"(lo), "v"(hi)); return r; }
typedef float f32x2 __attribute__((ext_vector_type(2)));
struct EpiBf16N {
    static constexpr bool PERM = true, AFTER_DRAIN = false;
    bf16_t* O; int ldc; int nvalid;
    __device__ __forceinline__ void operator()(const f32x4 (&acc)[2][2][4][2], const Unit& u, int wr, int wc, int fr, int fq) const {
        const int row0 = u.pm * BM + wr * 64 + fr, col0 = u.pn * BM + wc * 32 + 8 * fq;
#pragma unroll
        for (int ai = 0; ai < 2; ++ai)
#pragma unroll
            for (int m = 0; m < 4; ++m) { bf16_t* rowp = O + (size_t)(row0 + ai * HALF + m * 16) * ldc;
#pragma unroll
                for (int bj = 0; bj < 2; ++bj) { const int c = col0 + bj * HALF; const f32x4 v0 = acc[ai][bj][m][0], v1 = acc[ai][bj][m][1];
                    u32x4 w; w.x = cvt_pk_bf16(v0[0], v0[1]); w.y = cvt_pk_bf16(v0[2], v0[3]); w.z = cvt_pk_bf16(v1[0], v1[1]); w.w = cvt_pk_bf16(v1[2], v1[3]);
                    if (c < nvalid) *(u32x4*)(rowp + c) = w; } }
    }
};
struct EpiF32 {
    static constexpr bool PERM = true, AFTER_DRAIN = false;
    float* O; int ldc;
    __device__ __forceinline__ void operator()(const f32x4 (&acc)[2][2][4][2], const Unit& u, int wr, int wc, int fr, int fq) const {
        const int row0 = u.pm * BM + wr * 64 + fr, col0 = u.pn * BM + wc * 32 + 8 * fq;
#pragma unroll
        for (int ai = 0; ai < 2; ++ai)
#pragma unroll
            for (int m = 0; m < 4; ++m) { float* rowp = O + (size_t)(row0 + ai * HALF + m * 16) * ldc + col0;
#pragma unroll
                for (int bj = 0; bj < 2; ++bj) { *(f32x4*)(rowp + bj * HALF) = acc[ai][bj][m][0]; *(f32x4*)(rowp + bj * HALF + 4) = acc[ai][bj][m][1]; } }
    }
};
struct EpiSwiGLU {
    static constexpr bool PERM = true, AFTER_DRAIN = false;
    bf16_t* O; int ldc;
    __device__ __forceinline__ void operator()(const f32x4 (&acc)[2][2][4][2], const Unit& u, int wr, int wc, int fr, int fq) const {
        const int row0 = u.pm * BM + wr * 64 + fr, col0 = u.pn * HALF + wc * 32 + 8 * fq;
#pragma unroll
        for (int ai = 0; ai < 2; ++ai)
#pragma unroll
            for (int m = 0; m < 4; ++m) { bf16_t* rowp = O + (size_t)(row0 + ai * HALF + m * 16) * ldc + col0;
                float h[8];
#pragma unroll
                for (int n = 0; n < 2; ++n)
#pragma unroll
                    for (int j = 0; j < 4; ++j) { const float g = acc[ai][0][m][n][j], up = acc[ai][1][m][n][j]; h[n * 4 + j] = g * __builtin_amdgcn_rcpf(1.f + __expf(-g)) * up; }
                u32x4 w; w.x = cvt_pk_bf16(h[0], h[1]); w.y = cvt_pk_bf16(h[2], h[3]); w.z = cvt_pk_bf16(h[4], h[5]); w.w = cvt_pk_bf16(h[6], h[7]);
                *(u32x4*)rowp = w; }
    }
};
template <class Epi, class Sched, bool ALIGN_EPI = false, bool SP2 = false>
__device__ __forceinline__ void gemm_phase(PG8_LAS unsigned char* lds, const Gemm g, const Sched& S, const Epi& E) {
    int tid = threadIdx.x; asm volatile("" : "+v"(tid)); const int wid = __builtin_amdgcn_readfirstlane(tid >> 6), lane = tid & 63, wr = wid >> 2, wc = wid & 3, fr = lane & 15, fq = lane >> 4;
    const int K = g.K, nt = K / BK;
    unsigned voffA[2], voffB[2];
#pragma unroll
    for (int i = 0; i < 2; ++i) { int R, C; stage_rc(tid * 16 + i * 8192, R, C); const int Rb = Epi::PERM ? ((R & ~31) + perm32(R & 31)) : R;
        voffA[i] = (unsigned)(R * K + C) * 2u; voffB[i] = (unsigned)(Rb * K + C) * 2u; }
    const size_t kstep = (size_t)(BK * 2);
    const size_t hstep = (size_t)HALF * K * 2;
    const size_t tstep = 2 * hstep;
    const unsigned ldsw = (unsigned)wid * 1024u;
    const int aoff = lds_byte(wr * 64 + fr, fq * 8), boff = lds_byte(wc * 32 + fr, fq * 8);
#define PG8_SA(b, h) (((b) * 2 + (h)) * HTB)
#define PG8_SB(b, h) ((4 + (b) * 2 + (h)) * HTB)
#define PG8_STAGE(bufoff, gbase, voff) do { _Pragma("unroll") for (int _i = 0; _i < 2; ++_i) \
        __builtin_amdgcn_global_load_lds((const unsigned*)((const char*)(gbase) + (voff)[_i]), (PG8_LAS unsigned*)(lds + (bufoff) + ldsw + _i * 8192), 16, 0, 0); } while (0)
#define PG8_LDA(dst, b, h) do { _Pragma("unroll") for (int m = 0; m < 4; ++m) _Pragma("unroll") for (int k = 0; k < 2; ++k) dst[m][k] = *(const PG8_LAS bf16x8*)(lds + PG8_SA(b, h) + aoff + m * 2048 + k * 1024); } while (0)
#define PG8_LDB(dst, b, h) do { _Pragma("unroll") for (int n = 0; n < 2; ++n) _Pragma("unroll") for (int k = 0; k < 2; ++k) dst[n][k] = *(const PG8_LAS bf16x8*)(lds + PG8_SB(b, h) + boff + n * 2048 + k * 1024); } while (0)
#define PG8_MMA(ai, bj, At, Bt) do { __builtin_amdgcn_s_setprio(1); _Pragma("unroll") for (int m = 0; m < 4; ++m) _Pragma("unroll") for (int n = 0; n < 2; ++n) _Pragma("unroll") for (int k = 0; k < 2; ++k) \
        acc[ai][bj][m][n] = __builtin_amdgcn_mfma_f32_16x16x32_bf16(Bt[n][k], At[m][k], acc[ai][bj][m][n], 0, 0, 0); __builtin_amdgcn_s_setprio(0); } while (0)
#define PG8_WAIT_V(n) asm volatile("s_waitcnt vmcnt(" #n ")" ::: "memory")
#define PG8_WAIT_L(n) asm volatile("s_waitcnt lgkmcnt(" #n ")" ::: "memory")
#define PG8_BAR __builtin_amdgcn_s_barrier()
#define PG8_SCHED __builtin_amdgcn_sched_barrier(0)
    Unit cur, nxt; int ui = 0;
    if (!S.next(0, cur)) return;
    f32x4 acc[2][2][4][2];
#pragma unroll
    for (int a = 0; a < 2; ++a)
#pragma unroll
        for (int b = 0; b < 2; ++b)
#pragma unroll
            for (int m = 0; m < 4; ++m)
#pragma unroll
                for (int n = 0; n < 2; ++n) acc[a][b][m][n] = (f32x4){0.f, 0.f, 0.f, 0.f};
    bf16x8 At[4][2], B0[2][2], B1[2][2];
    const char* cA = (const char*)g.A + (size_t)cur.pm * tstep; const char* cB = (const char*)g.Bt + (size_t)cur.pn * tstep;
    S.a_ready(cur);
    if constexpr (SP2) {
        PG8_STAGE(PG8_SB(0, 0), cB, voffB); PG8_STAGE(PG8_SB(0, 1), cB + hstep, voffB); PG8_STAGE(PG8_SA(0, 0), cA, voffA); PG8_STAGE(PG8_SA(0, 1), cA + hstep, voffA);
        if (wr == 1) PG8_BAR;
        PG8_WAIT_V(2); PG8_BAR;
        PG8_STAGE(PG8_SB(1, 0), cB + kstep, voffB); PG8_STAGE(PG8_SA(1, 0), cA + kstep, voffA); PG8_STAGE(PG8_SB(1, 1), cB + hstep + kstep, voffB);
        PG8_WAIT_V(6); PG8_BAR;
    } else {
        PG8_STAGE(PG8_SB(0, 0), cB, voffB); PG8_STAGE(PG8_SA(0, 0), cA, voffA); PG8_STAGE(PG8_SB(0, 1), cB + hstep, voffB); PG8_STAGE(PG8_SA(0, 1), cA + hstep, voffA);
        if (wr == 1) PG8_BAR;
        PG8_WAIT_V(4); PG8_BAR;
        PG8_STAGE(PG8_SB(1, 0), cB + kstep, voffB); PG8_STAGE(PG8_SA(1, 0), cA + kstep, voffA); PG8_STAGE(PG8_SB(1, 1), cB + hstep + kstep, voffB);
        PG8_WAIT_V(6); PG8_BAR;
    }
    for (;;) {
        const bool has_next = S.next(ui + 1, nxt);
        const char* nA = has_next ? (const char*)g.A + (size_t)nxt.pm * tstep : cA; const char* nB = has_next ? (const char*)g.Bt + (size_t)nxt.pn * tstep : cB;
        for (int t = 0; t < nt; t += 2) {
            const bool last = (t == nt - 2);
            const char* a1 = cA + (size_t)(t + 1) * kstep;
            const char* a2 = last ? nA : cA + (size_t)(t + 2) * kstep; const char* b2 = last ? nB : cB + (size_t)(t + 2) * kstep;
            const char* a3 = a2 + kstep; const char* b3 = b2 + kstep;
            if (last && has_next) S.a_ready(nxt);
            if constexpr (SP2) {
            PG8_LDB(B0, 0, 0); PG8_LDB(B1, 0, 1); PG8_SCHED; PG8_LDA(At, 0, 0); PG8_STAGE(PG8_SA(1, 1), a1 + hstep, voffA);
            PG8_WAIT_V(8); PG8_WAIT_L(0); PG8_BAR; PG8_MMA(0, 0, At, B0); PG8_MMA(0, 1, At, B1); PG8_BAR; PG8_SCHED;
            PG8_LDA(At, 0, 1); PG8_STAGE(PG8_SB(0, 0), b2, voffB); PG8_STAGE(PG8_SB(0, 1), b2 + hstep, voffB); PG8_STAGE(PG8_SA(0, 0), a2, voffA);
            PG8_WAIT_V(8); PG8_WAIT_L(0); PG8_BAR; PG8_MMA(1, 0, At, B0); PG8_MMA(1, 1, At, B1); PG8_BAR; PG8_SCHED;
            PG8_LDB(B0, 1, 0); PG8_LDB(B1, 1, 1); PG8_SCHED; PG8_LDA(At, 1, 0); PG8_STAGE(PG8_SA(0, 1), a2 + hstep, voffA);
            PG8_WAIT_V(8); PG8_WAIT_L(0); PG8_BAR; PG8_MMA(0, 0, At, B0); PG8_MMA(0, 1, At, B1); PG8_BAR; PG8_SCHED;
            PG8_LDA(At, 1, 1); PG8_STAGE(PG8_SB(1, 0), b3, voffB); PG8_STAGE(PG8_SB(1, 1), b3 + hstep, voffB); PG8_STAGE(PG8_SA(1, 0), a3, voffA);
            PG8_WAIT_V(8); PG8_WAIT_L(0); PG8_BAR; PG8_MMA(1, 0, At, B0); PG8_MMA(1, 1, At, B1); PG8_BAR; PG8_SCHED;
            } else {
            PG8_LDB(B0, 0, 0); PG8_SCHED; PG8_LDA(At, 0, 0); PG8_STAGE(PG8_SA(1, 1), a1 + hstep, voffA);
            PG8_WAIT_L(8); PG8_BAR; PG8_WAIT_L(0); PG8_MMA(0, 0, At, B0); PG8_BAR; PG8_SCHED;
            PG8_LDB(B1, 0, 1); PG8_STAGE(PG8_SB(0, 0), b2, voffB);
            PG8_BAR; PG8_WAIT_L(0); PG8_MMA(0, 1, At, B1); PG8_BAR;
            PG8_LDA(At, 0, 1); PG8_STAGE(PG8_SA(0, 0), a2, voffA);
            PG8_BAR; PG8_WAIT_L(0); PG8_MMA(1, 0, At, B0); PG8_BAR; PG8_SCHED;
            PG8_STAGE(PG8_SB(0, 1), b2 + hstep, voffB);
            PG8_WAIT_V(6); PG8_BAR; PG8_MMA(1, 1, At, B1); PG8_BAR;
            PG8_LDB(B0, 1, 0); PG8_SCHED; PG8_LDA(At, 1, 0); PG8_STAGE(PG8_SA(0, 1), a2 + hstep, voffA);
            PG8_WAIT_L(8); PG8_BAR; PG8_WAIT_L(0); PG8_MMA(0, 0, At, B0); PG8_BAR; PG8_SCHED;
            PG8_LDB(B1, 1, 1); PG8_STAGE(PG8_SB(1, 0), b3, voffB);
            PG8_BAR; PG8_WAIT_L(0); PG8_MMA(0, 1, At, B1); PG8_BAR;
            PG8_LDA(At, 1, 1); PG8_STAGE(PG8_SA(1, 0), a3, voffA);
            PG8_BAR; PG8_WAIT_L(0); PG8_MMA(1, 0, At, B0); PG8_BAR; PG8_SCHED;
            PG8_STAGE(PG8_SB(1, 1), b3 + hstep, voffB);
            PG8_WAIT_V(6); PG8_BAR; PG8_MMA(1, 1, At, B1); PG8_BAR;
            }
        }
        if constexpr (ALIGN_EPI) { if (wr == 0) PG8_BAR; }
        if constexpr (!Epi::AFTER_DRAIN) { E(acc, cur, wr, wc, fr, fq); S.done(cur); }
        if (!has_next) break;
#pragma unroll
        for (int a = 0; a < 2; ++a)
#pragma unroll
            for (int b = 0; b < 2; ++b)
#pragma unroll
                for (int m = 0; m < 4; ++m)
#pragma unroll
                    for (int n = 0; n < 2; ++n) acc[a][b][m][n] = (f32x4){0.f, 0.f, 0.f, 0.f};
        cur = nxt; cA = nA; cB = nB; ++ui;
        if constexpr (ALIGN_EPI) { if (wr == 1) PG8_BAR; }
    }
    PG8_WAIT_V(0);
    if constexpr (!ALIGN_EPI) { if (wr == 0) PG8_BAR; }
    PG8_BAR;
    if constexpr (Epi::AFTER_DRAIN) { E.fused(acc, cur, wr, wc, fr, fq, lds, wid, lane); S.done(cur); }
#undef PG8_SA
#undef PG8_SB
#undef PG8_STAGE
#undef PG8_LDA
#undef PG8_LDB
#undef PG8_MMA
#undef PG8_WAIT_V
#undef PG8_WAIT_L
#undef PG8_BAR
#undef PG8_SCHED
}
}
#define LAS __attribute__((address_space(3)))
typedef unsigned short bf16_t;
typedef short bf16x8 __attribute__((ext_vector_type(8)));
typedef float f32x4 __attribute__((ext_vector_type(4)));
typedef float f32x16 __attribute__((ext_vector_type(16)));
typedef unsigned u32x4 __attribute__((ext_vector_type(4)));
typedef unsigned u32x2 __attribute__((ext_vector_type(2)));

constexpr int D = 1024, NB = 8, SEQ = 4096, CTX = 256, DEPTH = 4;
constexpr int NLAT = NB * SEQ, NCTX = NB * CTX, MROWS = NLAT + NCTX;
constexpr int NIN = 2336, NINP = 2560, DFF = 2816;
constexpr int OFF_Q = 0, OFF_K = 256, OFF_V = 512, OFF_DEC = 1024, OFF_OG = 1056, OFF_F = 1568, OFF_RX = 1824, OFF_RG = 2080;
constexpr int NCHUNK = MROWS / 64;
constexpr float EPS = 1e-6f;
constexpr int NTHREADS = 512, NWAVES = 8;
constexpr int LDS_BYTES = 147456 + 256;
constexpr int MISC_OFF = 147456;
constexpr int TAB_OFF = 147456 - 34816;

constexpr size_t MiB = 1u << 20;
constexpr size_t WS_WIN = 0, WS_WOUT = 20 * MiB, WS_WGU = 28 * MiB, WS_WDN = 72 * MiB, WS_MOD = 94 * MiB, WS_WRG = 95 * MiB, WS_DEC = 96 * MiB,
                 WS_RGS = 98 * MiB, WS_HST = 101 * MiB, WS_XC = 103 * MiB, WS_HY = 111 * MiB, WS_A = 179 * MiB, WS_B = 366 * MiB, WS_FZ = 434 * MiB, WS_END = 502 * MiB, WS_CTL = 510 * MiB, CTL_BYTES = 16384;

struct Params { const float* in[25]; float* out; unsigned char* ws; int ph_lo, ph_hi; };
enum { I_X = 0, I_C, I_CTX, I_CCTX, I_WADA, I_BADA, I_GPREMIX, I_GPOSTMIX, I_GPREFFN, I_GPOSTFFN, I_WIN, I_WDEC, I_BDEC, I_GGLA, I_WCONV, I_BCONV,
       I_WRGA, I_BRGA, I_WRGX, I_BRGX, I_RGLAM, I_WOUT, I_WGATE, I_WUP, I_WDOWN };

__device__ __forceinline__ int tid_opaque() { int t = threadIdx.x; asm volatile("" : "+v"(t)); return t; }
__device__ __forceinline__ unsigned f2bf(float f) { unsigned u = __builtin_bit_cast(unsigned, f); return (u + 0x7fffu + ((u >> 16) & 1u)) >> 16; }
__device__ __forceinline__ unsigned pk2(float lo, float hi) { return f2bf(lo) | (f2bf(hi) << 16); }
__device__ __forceinline__ float bflo(unsigned w) { return __builtin_bit_cast(float, w << 16); }
__device__ __forceinline__ float bfhi(unsigned w) { return __builtin_bit_cast(float, w & 0xffff0000u); }
__device__ __forceinline__ float bf1(unsigned short h) { return __builtin_bit_cast(float, (unsigned)h << 16); }
#define BFE(v, i) (((i) & 1) ? bfhi((v)[(i) >> 1]) : bflo((v)[(i) >> 1]))
__device__ __forceinline__ float wave_sum(float v) {
#pragma unroll
    for (int o = 1; o < 64; o <<= 1) v += __shfl_xor(v, o);
    return v;
}
__device__ __forceinline__ float sigmoidf_(float x) { return __builtin_amdgcn_rcpf(1.f + __expf(-x)); }
__device__ __forceinline__ bf16x8 ldv(const LAS bf16_t* p) { return *(const LAS bf16x8*)p; }
__device__ __forceinline__ bf16x8 ldv(const bf16_t* p) { return *(const bf16x8*)p; }
template <class PA, class PB> __device__ __forceinline__ void mma64(f32x16& acc, PA a, PB b) {
#pragma unroll
    for (int k0 = 0; k0 < 64; k0 += 16) acc = __builtin_amdgcn_mfma_f32_32x32x16_bf16(ldv(a + k0), ldv(b + k0), acc, 0, 0, 0);
}
#define ACC_ROW(reg, hi) (((reg) & 3) + 8 * ((reg) >> 2) + 4 * (hi))
#define ZERO16 ((f32x16){0.f,0.f,0.f,0.f,0.f,0.f,0.f,0.f,0.f,0.f,0.f,0.f,0.f,0.f,0.f,0.f})

__device__ __forceinline__ void transpose_item(const float* W, int N, bf16_t* WT, int ldk, int k0, int n0, int drow0, LAS float* scr, int lane) {
#pragma unroll 8
    for (int i = 0; i < 32; ++i) { const int kk = 2 * i + (lane >> 5); scr[kk * 33 + (lane & 31)] = W[(size_t)(k0 + kk) * N + n0 + (lane & 31)]; }
    asm volatile("s_waitcnt lgkmcnt(0)" ::: "memory");
    const int c = lane & 7;
#pragma unroll
    for (int j = 0; j < 4; ++j) { const int n = (lane >> 3) + 8 * j; const LAS float* s = scr + (8 * c) * 33 + n;
        u32x4 o; o.x = pk2(s[0 * 33], s[1 * 33]); o.y = pk2(s[2 * 33], s[3 * 33]); o.z = pk2(s[4 * 33], s[5 * 33]); o.w = pk2(s[6 * 33], s[7 * 33]);
        *(u32x4*)(WT + (size_t)(drow0 + n) * ldk + k0 + 8 * c) = o; }
    asm volatile("s_waitcnt lgkmcnt(0)" ::: "memory");
}

__device__ __forceinline__ void phase_prologue(const Params& p, LAS unsigned char* L) {
    const int tid = tid_opaque(), lane = tid & 63, wave = tid >> 6;
    unsigned char* ws = p.ws;
    {
        LAS float* scr = (LAS float*)(L + wave * 16384);
        const int gw = blockIdx.x * NWAVES + wave, NGW = gridDim.x * NWAVES;
        constexpr int I_IN = 16 * 73, I_OUT = 16 * 32, I_G = 16 * 88, I_DN = 44 * 32, I_L = I_IN + I_OUT + 2 * I_G + I_DN;
        for (int it = gw; it < DEPTH * I_L; it += NGW) {
            const int l = it / I_L; int r = it % I_L;
            if (r < I_IN) { const int kb = r / 73, nb = r % 73; transpose_item(p.in[I_WIN] + (size_t)l * D * NIN, NIN, (bf16_t*)(ws + WS_WIN) + (size_t)l * NINP * D, D, kb * 64, nb * 32, nb * 32, scr, lane); continue; }
            r -= I_IN;
            if (r < I_OUT) { const int kb = r / 32, nb = r % 32; transpose_item(p.in[I_WOUT] + (size_t)l * D * D, D, (bf16_t*)(ws + WS_WOUT) + (size_t)l * D * D, D, kb * 64, nb * 32, nb * 32, scr, lane); continue; }
            r -= I_OUT;
            if (r < 2 * I_G) { const int up = r >= I_G; if (up) r -= I_G; const int kb = r / 88, nb = r % 88, n0 = nb * 32;
                transpose_item(p.in[up ? I_WUP : I_WGATE] + (size_t)l * D * DFF, DFF, (bf16_t*)(ws + WS_WGU) + (size_t)l * 2 * DFF * D, D, kb * 64, n0, 256 * (n0 >> 7) + (n0 & 127) + (up ? 128 : 0), scr, lane); continue; }
            r -= 2 * I_G;
            { const int kb = r / 32, nb = r % 32; transpose_item(p.in[I_WDOWN] + (size_t)l * DFF * D, D, (bf16_t*)(ws + WS_WDN) + (size_t)l * D * DFF, DFF, kb * 64, nb * 32, nb * 32, scr, lane); }
        }
        const int gt = blockIdx.x * NTHREADS + tid, NGT = gridDim.x * NTHREADS;
        constexpr int PADV = (NINP - NIN) * D / 8;
        for (int i = gt; i < DEPTH * PADV; i += NGT) { const int l = i / PADV, q = i % PADV;
            *(u32x4*)((bf16_t*)(ws + WS_WIN) + (size_t)l * NINP * D + (size_t)NIN * D + (size_t)q * 8) = (u32x4){0u, 0u, 0u, 0u}; }
        for (int i = gt; i < DEPTH * 2 * 2 * 4 * 4096; i += NGT) {
            const int in_ = i & 63, out_ = (i >> 6) & 63, head = (i >> 12) & 3, ax = (i >> 14) & 1, dir = (i >> 15) & 1, l = i >> 16;
            const float* W = p.in[ax ? I_WRGX : I_WRGA];
            ((bf16_t*)(ws + WS_WRG))[i] = (bf16_t)f2bf(W[((((size_t)l * 2 + dir) * 4 + head) * 64 + in_) * 64 + out_]);
        }
    }
    __syncthreads();
    {
        LAS float* sl = (LAS float*)L;
        LAS float* red = (LAS float*)(L + 36864);
        for (int i = tid; i < 9 * 1024; i += NTHREADS) { const int r = i >> 10, k = i & 1023; const float v = (r < 8) ? p.in[I_C][r * 1024 + k] : p.in[I_CCTX][k]; sl[i] = v / (1.f + __expf(-v)); }
        __syncthreads();
        float* MOD = (float*)(ws + WS_MOD);
        for (int item = blockIdx.x; item < DEPTH * 96; item += gridDim.x) {
            const int l = item / 96, cb = item % 96, cc = tid & 63, kg = tid >> 6;
            const float* w = p.in[I_WADA] + ((size_t)l * 1024 + kg * 128) * 6144 + cb * 64 + cc;
            float a0 = 0.f, a1 = 0.f, a2 = 0.f, a3 = 0.f, a4 = 0.f, a5 = 0.f, a6 = 0.f, a7 = 0.f, a8 = 0.f;
            const LAS float* s = sl + kg * 128;
#pragma unroll 8
            for (int k = 0; k < 128; ++k) { const float wv = w[(size_t)k * 6144];
                a0 += s[k] * wv; a1 += s[1024 + k] * wv; a2 += s[2048 + k] * wv; a3 += s[3072 + k] * wv; a4 += s[4096 + k] * wv;
                a5 += s[5120 + k] * wv; a6 += s[6144 + k] * wv; a7 += s[7168 + k] * wv; a8 += s[8192 + k] * wv; }
            LAS float* rp = red + kg * 576 + cc;
            rp[0] = a0; rp[64] = a1; rp[128] = a2; rp[192] = a3; rp[256] = a4; rp[320] = a5; rp[384] = a6; rp[448] = a7; rp[512] = a8;
            __syncthreads();
            for (int i = tid; i < 576; i += NTHREADS) { float sum = 0.f;
#pragma unroll
                for (int g = 0; g < 8; ++g) sum += red[g * 576 + i];
                const int r = i >> 6, c2 = i & 63; MOD[((size_t)l * 9 + r) * 6144 + cb * 64 + c2] = sum + p.in[I_BADA][l * 6144 + cb * 64 + c2]; }
            __syncthreads();
        }
    }
}

__device__ __forceinline__ void rows_phase(const Params& p, const bool HAS_T, int nrows, const float* xlat_src, const float* xctx_src, const float* T, const float* gpost, const float* modT, int gt_off,
                                           bool want_h, const float* gpre, const float* modH, int sh_off, int sc_off) {
    const int tid = tid_opaque(), lane = tid & 63, wave = tid >> 6;
    const int gw = blockIdx.x * NWAVES + wave, NGW = gridDim.x * NWAVES;
    float* xlat_dst = p.out; float* xctx_dst = (float*)(p.ws + WS_XC); bf16_t* H = (bf16_t*)(p.ws + WS_HY);
    for (int row = gw; row < nrows; row += NGW) {
        const bool isctx = row >= NLAT; const int mrow = isctx ? 8 : (row >> 12);
        const float* xs = isctx ? xctx_src + (size_t)(row - NLAT) * D : xlat_src + (size_t)row * D;
        f32x4 x[4];
#pragma unroll
        for (int j = 0; j < 4; ++j) x[j] = *(const f32x4*)(xs + 4 * lane + 256 * j);
        if (HAS_T) {
            f32x4 t[4]; float ss = 0.f;
#pragma unroll
            for (int j = 0; j < 4; ++j) { t[j] = *(const f32x4*)(T + (size_t)row * D + 4 * lane + 256 * j); ss += t[j].x * t[j].x + t[j].y * t[j].y + t[j].z * t[j].z + t[j].w * t[j].w; }
            const float rstd = rsqrtf(wave_sum(ss) * (1.f / D) + EPS);
            const float* mt = modT + (size_t)mrow * 6144 + gt_off;
            float* xd = isctx ? xctx_dst + (size_t)(row - NLAT) * D : xlat_dst + (size_t)row * D;
#pragma unroll
            for (int j = 0; j < 4; ++j) { const f32x4 g = *(const f32x4*)(gpost + 4 * lane + 256 * j), gt = *(const f32x4*)(mt + 4 * lane + 256 * j);
                x[j] = x[j] + gt * (t[j] * rstd * g); *(f32x4*)(xd + 4 * lane + 256 * j) = x[j]; }
        }
        if (want_h) {
            float ss = 0.f;
#pragma unroll
            for (int j = 0; j < 4; ++j) ss += x[j].x * x[j].x + x[j].y * x[j].y + x[j].z * x[j].z + x[j].w * x[j].w;
            const float rstd = rsqrtf(wave_sum(ss) * (1.f / D) + EPS);
            const float* mh = modH + (size_t)mrow * 6144;
#pragma unroll
            for (int j = 0; j < 4; ++j) { const f32x4 g = *(const f32x4*)(gpre + 4 * lane + 256 * j), sh = *(const f32x4*)(mh + sh_off + 4 * lane + 256 * j), sc = *(const f32x4*)(mh + sc_off + 4 * lane + 256 * j);
                const f32x4 h = (x[j] * rstd * g) * (sc + 1.f) + sh;
                u32x2 o; o.x = pk2(h.x, h.y); o.y = pk2(h.z, h.w); *(u32x2*)(H + (size_t)row * D + 4 * lane + 256 * j) = o; }
        }
    }
}

__device__ __forceinline__ int scan_cid(int b, int dir, int s) { return (s < 4) ? (512 + b * 4 + (dir ? 3 - s : s)) : (b * 64 + (dir ? 63 - (s - 4) : (s - 4))); }

constexpr int G_LR = 0, G_SEG = 8192, G_CUM = 10240, G_TOT = 43008, G_T0 = 43520;
struct GlaIn { u32x4 zdec, qv, kv, vv0, vv1, og0, og1; };
template <bool G3> __device__ __forceinline__ GlaIn gla_load(const bf16_t* Z, int cid, int h, int tid) {
    GlaIn r; const int r0 = cid * 64, t = tid >> 3, q8 = tid & 7; const bf16_t* zr = Z + (size_t)(r0 + t) * NIN;
    r.zdec = *(const u32x4*)(Z + (size_t)(r0 + ((tid >> 2) & 63)) * NIN + OFF_DEC + (tid & 3) * 8);
    r.kv = *(const u32x4*)(zr + OFF_K + h * 64 + q8 * 8);
    r.vv0 = *(const u32x4*)(zr + OFF_V + h * 128 + q8 * 16); r.vv1 = *(const u32x4*)(zr + OFF_V + h * 128 + q8 * 16 + 8);
    if (G3) { r.qv = *(const u32x4*)(zr + OFF_Q + h * 64 + q8 * 8); r.og0 = *(const u32x4*)(zr + OFF_OG + h * 128 + q8 * 16); r.og1 = *(const u32x4*)(zr + OFF_OG + h * 128 + q8 * 16 + 8); }
    else { r.qv = r.kv; r.og0 = r.kv; r.og1 = r.kv; }
    return r;
}
__device__ __forceinline__ void gla_decays(LAS unsigned char* L, const u32x4& zdec, const float (&w)[16], float bias, int tid) {
    LAS float* LR = (LAS float*)(L + G_LR); LAS float* SEG = (LAS float*)(L + G_SEG); LAS float* CUM = (LAS float*)(L + G_CUM); LAS float* TOT = (LAS float*)(L + G_TOT);
    if (tid < 256) { const int t = tid >> 2, q = tid & 3;
#pragma unroll
        for (int i = 0; i < 8; ++i) LR[t * 32 + q * 8 + i] = BFE(zdec, i); }
    __syncthreads();
    const int d = tid >> 8, k = tid & 63, tq = (tid >> 6) & 3;
    float la[16];
#pragma unroll
    for (int i = 0; i < 16; ++i) { const LAS float* lr = LR + (tq * 16 + i) * 32 + d * 16; float logit = bias;
#pragma unroll
        for (int r = 0; r < 16; ++r) logit += lr[r] * w[r];
        la[i] = (fminf(logit, 0.f) - __logf(1.f + __expf(-fabsf(logit)))) * (1.f / 16.f); }
    if (d == 0) {
#pragma unroll
        for (int i = 1; i < 16; ++i) la[i] += la[i - 1];
        SEG[(0 * 4 + tq) * 64 + k] = la[15];
    } else {
#pragma unroll
        for (int i = 14; i >= 0; --i) la[i] += la[i + 1];
        SEG[(1 * 4 + tq) * 64 + k] = la[0];
    }
    __syncthreads();
    float off = 0.f, tot = 0.f;
#pragma unroll
    for (int q = 0; q < 4; ++q) { const float sv = SEG[(d * 4 + q) * 64 + k]; tot += sv; if (d == 0 ? (q < tq) : (q > tq)) off += sv; }
#pragma unroll
    for (int i = 0; i < 16; ++i) CUM[(d * 64 + tq * 16 + i) * 64 + k] = la[i] + off;
    if (tq == 0) TOT[d * 64 + k] = tot;
    __syncthreads();
}
__device__ __forceinline__ void gla_vt(LAS bf16_t* VT, const u32x4& v0, const u32x4& v1, int tid) {
    const int t = tid >> 3, vq = tid & 7;
#pragma unroll
    for (int i = 0; i < 8; ++i) { VT[(vq * 16 + i) * 72 + t] = (bf16_t)((i & 1) ? (v0[i >> 1] >> 16) : (v0[i >> 1] & 0xffffu));
        VT[(vq * 16 + 8 + i) * 72 + t] = (bf16_t)((i & 1) ? (v1[i >> 1] >> 16) : (v1[i >> 1] & 0xffffu)); }
}
#define GLA_PHASE_CONSTS() \
    const int tid = tid_opaque(), lane = tid & 63, wave = tid >> 6, r = lane & 31, hi = lane >> 5; \
    const bf16_t* Z = (const bf16_t*)(p.ws + WS_A); \
    float w[16]; float bias; \
    { const int d = tid >> 8, k = tid & 63; \
      _Pragma("unroll") for (int rr = 0; rr < 16; ++rr) w[rr] = p.in[I_WDEC][(((size_t)l * 2 + d) * 16 + rr) * 256 + h * 64 + k]; \
      bias = p.in[I_BDEC][((size_t)l * 2 + d) * 256 + h * 64 + k]; }

__device__ __forceinline__ void gla_g1_loop(const Params& p, LAS unsigned char* L, int l, int j0, int G, int nitems) {
    if (j0 >= nitems) return;
    const int h = j0 & 3;
    GLA_PHASE_CONSTS();
    LAS float* CUM = (LAS float*)(L + G_CUM); LAS float* TOT = (LAS float*)(L + G_TOT);
    LAS bf16_t* KEF = (LAS bf16_t*)(L + G_T0); LAS bf16_t* KEB = (LAS bf16_t*)(L + G_T0 + 9216); LAS bf16_t* VT = (LAS bf16_t*)(L + G_T0 + 18432);
    GlaIn cur = gla_load<false>(Z, j0 >> 2, h, tid);
    for (int j = j0; j < nitems; j += G) {
        const int cid = j >> 2;
        GlaIn nxt = cur; if (j + G < nitems) nxt = gla_load<false>(Z, (j + G) >> 2, h, tid);
        gla_decays(L, cur.zdec, w, bias, tid);
        { const int t = tid >> 3, kq = tid & 7;
#pragma unroll
          for (int i = 0; i < 8; ++i) { const int k = kq * 8 + i; const float kval = BFE(cur.kv, i);
              KEF[k * 72 + t] = (bf16_t)f2bf(kval * __expf(TOT[k] - CUM[t * 64 + k]));
              KEB[k * 72 + t] = (bf16_t)f2bf(kval * __expf(TOT[64 + k] - CUM[(64 + t) * 64 + k])); } }
        gla_vt(VT, cur.vv0, cur.vv1, tid);
        __syncthreads();
        const int dvb = wave & 3, dkb = wave >> 2;
        f32x16 accf = ZERO16, accb = ZERO16;
        const LAS bf16_t* aF = KEF + (dkb * 32 + r) * 72 + 8 * hi; const LAS bf16_t* aB = KEB + (dkb * 32 + r) * 72 + 8 * hi; const LAS bf16_t* bV = VT + (dvb * 32 + r) * 72 + 8 * hi;
        mma64(accf, aF, bV); mma64(accb, aB, bV);
        bf16_t* US = (bf16_t*)(p.ws + WS_B);
        bf16_t* uf = US + ((size_t)((cid * 4 + h) * 2 + 0) * 128 + dvb * 32 + r) * 64 + dkb * 32 + 4 * hi;
        bf16_t* ub = US + ((size_t)((cid * 4 + h) * 2 + 1) * 128 + dvb * 32 + r) * 64 + dkb * 32 + 4 * hi;
#pragma unroll
        for (int g = 0; g < 4; ++g) { u32x2 o; o.x = pk2(accf[4 * g], accf[4 * g + 1]); o.y = pk2(accf[4 * g + 2], accf[4 * g + 3]); *(u32x2*)(uf + 8 * g) = o;
            o.x = pk2(accb[4 * g], accb[4 * g + 1]); o.y = pk2(accb[4 * g + 2], accb[4 * g + 3]); *(u32x2*)(ub + 8 * g) = o; }
        if (tid < 128) ((float*)(p.ws + WS_DEC))[(size_t)((cid * 4 + h) * 2 + (tid >> 6)) * 64 + (tid & 63)] = __expf(TOT[tid]);
        __syncthreads();
        cur = nxt;
    }
}

__device__ __forceinline__ void gla_g2(const Params& p, int item) {
    const int gid = item * NTHREADS + tid_opaque(), dk4 = gid & 15, dv = (gid >> 4) & 127, seq = gid >> 11, dir = seq & 1, h = (seq >> 1) & 3, b = seq >> 3;
    bf16_t* US = (bf16_t*)(p.ws + WS_B); const float* DEC = (const float*)(p.ws + WS_DEC);
    float s0 = 0.f, s1 = 0.f, s2 = 0.f, s3 = 0.f;
#pragma unroll 17
    for (int s = 0; s < 68; ++s) {
        const int cid = scan_cid(b, dir, s); const size_t tile = (size_t)((cid * 4 + h) * 2 + dir);
        u32x2* up = (u32x2*)(US + (tile * 128 + dv) * 64 + dk4 * 4);
        const u32x2 u = *up; const f32x4 d = *(const f32x4*)(DEC + tile * 64 + dk4 * 4);
        u32x2 o; o.x = pk2(s0, s1); o.y = pk2(s2, s3); *up = o;
        s0 = s0 * d.x + bflo(u.x); s1 = s1 * d.y + bfhi(u.x); s2 = s2 * d.z + bflo(u.y); s3 = s3 * d.w + bfhi(u.y);
    }
}

__device__ __forceinline__ void gla_g3_loop(const Params& p, LAS unsigned char* L, int l, int j0, int G, int nitems) {
    if (j0 >= nitems) return;
    const int h = j0 & 3;
    GLA_PHASE_CONSTS();
    LAS float* CUM = (LAS float*)(L + G_CUM);
    LAS bf16_t* QF = (LAS bf16_t*)(L + G_T0); LAS bf16_t* KF = (LAS bf16_t*)(L + G_T0 + 9216); LAS bf16_t* QB = (LAS bf16_t*)(L + G_T0 + 18432); LAS bf16_t* KB = (LAS bf16_t*)(L + G_T0 + 27648);
    LAS bf16_t* VT = (LAS bf16_t*)(L + G_T0 + 36864); LAS bf16_t* AF = (LAS bf16_t*)(L + G_T0 + 55296); LAS bf16_t* AB = (LAS bf16_t*)(L + G_T0 + 64512);
    LAS float* OST = (LAS float*)L;
    float gg[16];
#pragma unroll
    for (int i = 0; i < 16; ++i) gg[i] = p.in[I_GGLA][l * 128 + (tid & 7) * 16 + i];
    GlaIn cur = gla_load<true>(Z, j0 >> 2, h, tid);
    for (int j = j0; j < nitems; j += G) {
        const int cid = j >> 2, r0 = cid * 64;
        GlaIn nxt = cur; if (j + G < nitems) nxt = gla_load<true>(Z, (j + G) >> 2, h, tid);
        gla_decays(L, cur.zdec, w, bias, tid);
        { const int t = tid >> 3, kq = tid & 7;
          float qf[8], kf[8], qb[8], kb[8];
#pragma unroll
          for (int i = 0; i < 8; ++i) { const int k = kq * 8 + i; const float q = BFE(cur.qv, i) * 0.125f, kk = BFE(cur.kv, i), bw = CUM[t * 64 + k], cw = CUM[(64 + t) * 64 + k];
              qf[i] = q * __expf(bw); kf[i] = kk * __expf(-bw); qb[i] = q * __expf(cw); kb[i] = kk * __expf(-cw); }
          u32x4 o;
          o.x = pk2(qf[0], qf[1]); o.y = pk2(qf[2], qf[3]); o.z = pk2(qf[4], qf[5]); o.w = pk2(qf[6], qf[7]); *(LAS u32x4*)(QF + t * 72 + kq * 8) = o;
          o.x = pk2(kf[0], kf[1]); o.y = pk2(kf[2], kf[3]); o.z = pk2(kf[4], kf[5]); o.w = pk2(kf[6], kf[7]); *(LAS u32x4*)(KF + t * 72 + kq * 8) = o;
          o.x = pk2(qb[0], qb[1]); o.y = pk2(qb[2], qb[3]); o.z = pk2(qb[4], qb[5]); o.w = pk2(qb[6], qb[7]); *(LAS u32x4*)(QB + t * 72 + kq * 8) = o;
          o.x = pk2(kb[0], kb[1]); o.y = pk2(kb[2], kb[3]); o.z = pk2(kb[4], kb[5]); o.w = pk2(kb[6], kb[7]); *(LAS u32x4*)(KB + t * 72 + kq * 8) = o; }
        gla_vt(VT, cur.vv0, cur.vv1, tid);
        __syncthreads();
        {
          const int bw = wave >> 2, ib = wave & 1, jb = (wave >> 1) & 1;
          f32x16 acc = ZERO16;
          const bool live = bw ? (jb >= ib) : (jb <= ib);
          if (live) { if (bw) mma64(acc, QB + (ib * 32 + r) * 72 + 8 * hi, KB + (jb * 32 + r) * 72 + 8 * hi); else mma64(acc, QF + (ib * 32 + r) * 72 + 8 * hi, KF + (jb * 32 + r) * 72 + 8 * hi); }
          LAS bf16_t* AT = bw ? AB : AF; const int jj = jb * 32 + r;
#pragma unroll
          for (int reg = 0; reg < 16; ++reg) { const int i = ib * 32 + ACC_ROW(reg, hi); const bool keep = bw ? (jj >= i) : (jj <= i); AT[i * 72 + jj] = (bf16_t)f2bf(keep ? acc[reg] : 0.f); } }
        __syncthreads();
        const int tb = wave & 1, dvb = wave >> 1;
        f32x16 acc = ZERO16;
        { const bf16_t* US = (const bf16_t*)(p.ws + WS_B);
          const bf16_t* sF = US + ((size_t)((cid * 4 + h) * 2 + 0) * 128 + dvb * 32 + r) * 64 + 8 * hi; const bf16_t* sB = US + ((size_t)((cid * 4 + h) * 2 + 1) * 128 + dvb * 32 + r) * 64 + 8 * hi;
          mma64(acc, QF + (tb * 32 + r) * 72 + 8 * hi, sF); mma64(acc, QB + (tb * 32 + r) * 72 + 8 * hi, sB);
          const LAS bf16_t* bV = VT + (dvb * 32 + r) * 72 + 8 * hi;
          mma64(acc, AF + (tb * 32 + r) * 72 + 8 * hi, bV); mma64(acc, AB + (tb * 32 + r) * 72 + 8 * hi, bV); }
#pragma unroll
        for (int reg = 0; reg < 16; ++reg) OST[(tb * 32 + ACC_ROW(reg, hi)) * 132 + dvb * 32 + r] = acc[reg];
        __syncthreads();
        { const int t = tid >> 3, part = tid & 7; float o[16]; float ss = 0.f;
#pragma unroll
          for (int i = 0; i < 16; ++i) { o[i] = OST[t * 132 + part * 16 + i]; ss += o[i] * o[i]; }
          ss += __shfl_xor(ss, 1); ss += __shfl_xor(ss, 2); ss += __shfl_xor(ss, 4);
          const float rstd = rsqrtf(ss * (1.f / 128.f) + EPS);
          bf16_t* Y = (bf16_t*)(p.ws + WS_HY) + (size_t)(r0 + t) * D + h * 128 + part * 16;
          float y[16];
#pragma unroll
          for (int i = 0; i < 8; ++i) { const float z0 = BFE(cur.og0, i), z1 = BFE(cur.og1, i);
              y[i] = o[i] * rstd * gg[i] * (z0 * __builtin_amdgcn_rcpf(1.f + __expf(-z0))); y[8 + i] = o[8 + i] * rstd * gg[8 + i] * (z1 * __builtin_amdgcn_rcpf(1.f + __expf(-z1))); }
          u32x4 wv; wv.x = pk2(y[0], y[1]); wv.y = pk2(y[2], y[3]); wv.z = pk2(y[4], y[5]); wv.w = pk2(y[6], y[7]); *(u32x4*)Y = wv;
          wv.x = pk2(y[8], y[9]); wv.y = pk2(y[10], y[11]); wv.z = pk2(y[12], y[13]); wv.w = pk2(y[14], y[15]); *(u32x4*)(Y + 8) = wv; }
        __syncthreads();
        cur = nxt;
    }
}

constexpr int R_UB = 0, R_UF = 9216, R_AA = 25600, R_BX = 58368;
struct RgIn { u32x4 z0, z1, z2, z3, zg; };
template <bool FINAL> __device__ __forceinline__ RgIn rg_load(const bf16_t* Z, int cid, int head, int tid) {
    RgIn r; const int t = tid >> 3, cq = tid & 7, ch0 = head * 64 + cq * 8, r0 = cid * 64;
    int pos, len, lbase;
    if (cid < 512) { pos = t; len = 64; lbase = r0; } else { const int n = (cid - 512) & 3; pos = n * 64 + t; len = 256; lbase = r0 - n * 64; }
    const u32x4 zero = (u32x4){0u, 0u, 0u, 0u};
    const bf16_t* zp = Z + (size_t)(lbase + pos) * NIN + OFF_RX + ch0;
    r.z0 = (pos - 1 >= 0) ? *(const u32x4*)(zp - NIN) : zero;
    r.z1 = *(const u32x4*)zp;
    r.z2 = (pos + 1 < len) ? *(const u32x4*)(zp + NIN) : zero;
    r.z3 = (pos + 2 < len) ? *(const u32x4*)(zp + 2 * NIN) : zero;
    r.zg = FINAL ? *(const u32x4*)(Z + (size_t)(r0 + t) * NIN + OFF_RG + ch0) : zero;
    return r;
}
template <bool FINAL>
__device__ __forceinline__ void rg_loop(const Params& p, LAS unsigned char* L, int l, int j0, int G, int nitems) {
    if (j0 >= nitems) return;
    const int head = j0 & 3;
    const int tid = tid_opaque(), lane = tid & 63, wave = tid >> 6, r = lane & 31, hi = lane >> 5;
    const bf16_t* Z = (const bf16_t*)(p.ws + WS_A);
    LAS bf16_t* UB = (LAS bf16_t*)(L + R_UB); LAS float* UF = (LAS float*)(L + R_UF); LAS float* AA = (LAS float*)(L + R_AA); LAS float* BX = (LAS float*)(L + R_BX);
    float bc[8], wc0[8], wc1[8], wc2[8], wc3[8];
    { const int ch0 = head * 64 + (tid & 7) * 8;
#pragma unroll
      for (int i = 0; i < 8; ++i) { bc[i] = p.in[I_BCONV][l * 256 + ch0 + i]; wc0[i] = p.in[I_WCONV][((size_t)l * 4 + 0) * 256 + ch0 + i]; wc1[i] = p.in[I_WCONV][((size_t)l * 4 + 1) * 256 + ch0 + i];
          wc2[i] = p.in[I_WCONV][((size_t)l * 4 + 2) * 256 + ch0 + i]; wc3[i] = p.in[I_WCONV][((size_t)l * 4 + 3) * 256 + ch0 + i]; } }
    const int tb = wave & 1, ob = (wave >> 1) & 1, dirw = wave >> 2;
    bf16x8 fA[4], fX[4];
    { const bf16_t* WRG = (const bf16_t*)(p.ws + WS_WRG);
      const bf16_t* bA = WRG + ((((size_t)(l * 2 + dirw) * 2 + 0) * 4 + head) * 64 + ob * 32 + r) * 64 + 8 * hi;
      const bf16_t* bXw = WRG + ((((size_t)(l * 2 + dirw) * 2 + 1) * 4 + head) * 64 + ob * 32 + r) * 64 + 8 * hi;
#pragma unroll
      for (int k = 0; k < 4; ++k) { fA[k] = *(const bf16x8*)(bA + 16 * k); fX[k] = *(const bf16x8*)(bXw + 16 * k); } }
    const int chw = ob * 32 + r, gch = head * 64 + chw;
    const float ba = p.in[I_BRGA][(l * 2 + dirw) * 256 + gch], bx_ = p.in[I_BRGX][(l * 2 + dirw) * 256 + gch], lam = p.in[I_RGLAM][(l * 2 + dirw) * 256 + gch];
    const float sp = fmaxf(-lam, 0.f) + log1pf(__expf(-fabsf(lam)));
    RgIn cur = rg_load<FINAL>(Z, j0 >> 2, head, tid);
    for (int j = j0; j < nitems; j += G) {
        const int cid = j >> 2, r0 = cid * 64;
        RgIn nxt = cur; if (j + G < nitems) nxt = rg_load<FINAL>(Z, (j + G) >> 2, head, tid);
        float h0 = 0.f;
        if (FINAL && tid < 128) h0 = ((const float*)(p.ws + WS_HST))[(size_t)(cid * 2 + (tid >> 6)) * 256 + head * 64 + (tid & 63)];
        { const int t = tid >> 3, cq = tid & 7; float u[8];
#pragma unroll
          for (int i = 0; i < 8; ++i) u[i] = bc[i] + wc0[i] * BFE(cur.z0, i) + wc1[i] * BFE(cur.z1, i) + wc2[i] * BFE(cur.z2, i) + wc3[i] * BFE(cur.z3, i);
          u32x4 o; o.x = pk2(u[0], u[1]); o.y = pk2(u[2], u[3]); o.z = pk2(u[4], u[5]); o.w = pk2(u[6], u[7]); *(LAS u32x4*)(UB + t * 72 + cq * 8) = o;
          *(LAS f32x4*)(UF + t * 64 + cq * 8) = (f32x4){u[0], u[1], u[2], u[3]}; *(LAS f32x4*)(UF + t * 64 + cq * 8 + 4) = (f32x4){u[4], u[5], u[6], u[7]}; }
        __syncthreads();
        { const LAS bf16_t* aU = UB + (tb * 32 + r) * 72 + 8 * hi;
          f32x16 accA = ZERO16, accX = ZERO16;
#pragma unroll
          for (int k = 0; k < 4; ++k) { const bf16x8 av = ldv(aU + 16 * k); accA = __builtin_amdgcn_mfma_f32_32x32x16_bf16(av, fA[k], accA, 0, 0, 0); accX = __builtin_amdgcn_mfma_f32_32x32x16_bf16(av, fX[k], accX, 0, 0, 0); }
#pragma unroll
          for (int reg = 0; reg < 16; ++reg) { const int tt = tb * 32 + ACC_ROW(reg, hi);
              const float rr = sigmoidf_(accA[reg] + ba), ii = sigmoidf_(accX[reg] + bx_), loga = -8.f * rr * sp, a = __expf(loga), x2 = 2.f * loga;
              const float om = (x2 > -0.25f) ? -x2 * (1.f + 0.5f * x2 * (1.f + (1.f / 3.f) * x2 * (1.f + 0.25f * x2 * (1.f + 0.2f * x2)))) : 1.f - __expf(x2), mult = __builtin_amdgcn_sqrtf(om);
              AA[(dirw * 64 + tt) * 64 + chw] = a; BX[(dirw * 64 + tt) * 64 + chw] = mult * ii * UF[tt * 64 + chw]; } }
        __syncthreads();
        if (tid < 128) { const int dir = tid >> 6, ch = tid & 63;
            if (!FINAL) { float hh = 0.f, P = 1.f;
#pragma unroll 8
                for (int s = 0; s < 64; ++s) { const int t = dir ? 63 - s : s; const float a = AA[(dir * 64 + t) * 64 + ch]; hh = a * hh + BX[(dir * 64 + t) * 64 + ch]; P *= a; }
                float* RGS = (float*)(p.ws + WS_RGS) + (size_t)(((cid * 4 + head) * 2 + dir) * 2) * 64 + ch; RGS[0] = P; RGS[64] = hh;
            } else { float hh = h0;
#pragma unroll 8
                for (int s = 0; s < 64; ++s) { const int t = dir ? 63 - s : s; hh = AA[(dir * 64 + t) * 64 + ch] * hh + BX[(dir * 64 + t) * 64 + ch]; BX[(dir * 64 + t) * 64 + ch] = hh; } } }
        __syncthreads();
        if (FINAL) { const int t = tid >> 3, cq = tid & 7; float y[8];
#pragma unroll
            for (int i = 0; i < 8; ++i) { const float hs = BX[t * 64 + cq * 8 + i] + BX[(64 + t) * 64 + cq * 8 + i], z = BFE(cur.zg, i);
                const float yy = 0.7978845608028654f * (z + 0.044715f * z * z * z), ge = z * (1.f - __builtin_amdgcn_rcpf(1.f + __expf(2.f * yy))); y[i] = hs * ge; }
            u32x4 wv; wv.x = pk2(y[0], y[1]); wv.y = pk2(y[2], y[3]); wv.z = pk2(y[4], y[5]); wv.w = pk2(y[6], y[7]);
            *(u32x4*)((bf16_t*)(p.ws + WS_HY) + (size_t)(r0 + t) * D + 768 + head * 64 + cq * 8) = wv;
            __syncthreads(); }
        cur = nxt;
    }
}
__device__ __forceinline__ void rg_r2(const Params& p, int item) {
    const int gid = item * NTHREADS + tid_opaque(), ch = gid & 255, dir = (gid >> 8) & 1, b = gid >> 9, head = ch >> 6, c = ch & 63;
    const float* RGS = (const float*)(p.ws + WS_RGS); float* HST = (float*)(p.ws + WS_HST);
    float hh = 0.f;
#pragma unroll 4
    for (int s = 0; s < 68; ++s) { const int cid = scan_cid(b, dir, s); const float* q = RGS + (size_t)(((cid * 4 + head) * 2 + dir) * 2) * 64 + c;
        HST[(size_t)(cid * 2 + dir) * 256 + ch] = hh; hh = q[0] * hh + q[64]; }
}

__device__ __forceinline__ void fourier_tables(LAS unsigned char* L) {
    LAS bf16_t* CM = (LAS bf16_t*)(L + TAB_OFF); LAS bf16_t* SM = (LAS bf16_t*)(L + TAB_OFF + 9216); LAS float* COST = (LAS float*)(L + TAB_OFF + 18432);
    for (int i = tid_opaque(); i < 4096; i += NTHREADS) { COST[i] = cospif((float)i * (1.f / 2048.f)); const int rr = i >> 6, c = i & 63; const float a = (float)((rr * c) & 63) * (1.f / 32.f);
        CM[rr * 72 + c] = (bf16_t)f2bf(cospif(a)); SM[rr * 72 + c] = (bf16_t)f2bf(sinpif(a)); }
    __syncthreads();
}
__device__ __forceinline__ void fourier_f1(const Params& p, LAS unsigned char* L, int b, int g, int tab) {
    const int tid = tid_opaque(), lane = tid & 63, wave = tid >> 6, r = lane & 31, hi = lane >> 5;
    const bf16_t* Z = (const bf16_t*)(p.ws + WS_A); bf16_t* FZ = (bf16_t*)(p.ws + WS_FZ);
    const LAS bf16_t* CM = (const LAS bf16_t*)(L + TAB_OFF); const LAS bf16_t* SM = (const LAS bf16_t*)(L + TAB_OFF + 9216); const LAS float* COST = (const LAS float*)(L + TAB_OFF + 18432);
    const int set = wave >> 2, wl = wave & 3;
    LAS bf16_t* X = (LAS bf16_t*)(L + set * 27648); LAS bf16_t* AT = X + 4608; LAS bf16_t* BT = X + 9216;
    for (int it = 0; it < 4; ++it) {
#pragma unroll
        for (int s = 0; s < 2; ++s) { const int ta = tab * 8 + it * 2 + s, tb = tid >> 3, cq = tid & 7;
            *(LAS u32x4*)((LAS bf16_t*)(L + s * 27648) + tb * 72 + cq * 8) = *(const u32x4*)(Z + (size_t)(b * 4096 + 64 * tb + ta) * NIN + OFF_F + g * 64 + cq * 8); }
        __syncthreads();
        { const int tbb = wl & 1, mb = wl >> 1; f32x16 aC = ZERO16, aS = ZERO16;
          const LAS bf16_t* aX = X + (tbb * 32 + r) * 72 + 8 * hi;
          mma64(aC, aX, CM + (mb * 32 + r) * 72 + 8 * hi); mma64(aS, aX, SM + (mb * 32 + r) * 72 + 8 * hi);
          const int m = mb * 32 + r;
#pragma unroll
          for (int q = 0; q < 4; ++q) { u32x2 o; o.x = pk2(aC[4 * q], aC[4 * q + 1]); o.y = pk2(aC[4 * q + 2], aC[4 * q + 3]); *(LAS u32x2*)(AT + m * 72 + tbb * 32 + 8 * q + 4 * hi) = o;
              o.x = pk2(-aS[4 * q], -aS[4 * q + 1]); o.y = pk2(-aS[4 * q + 2], -aS[4 * q + 3]); *(LAS u32x2*)(BT + m * 72 + tbb * 32 + 8 * q + 4 * hi) = o; } }
        __syncthreads();
        { const int kab = wl & 1, mb = wl >> 1; f32x16 zr = ZERO16, z1 = ZERO16, z2 = ZERO16;
          const LAS bf16_t* aC = CM + (kab * 32 + r) * 72 + 8 * hi; const LAS bf16_t* aS = SM + (kab * 32 + r) * 72 + 8 * hi;
          const LAS bf16_t* bA = AT + (mb * 32 + r) * 72 + 8 * hi; const LAS bf16_t* bB = BT + (mb * 32 + r) * 72 + 8 * hi;
          mma64(zr, aC, bA); mma64(zr, aS, bB); mma64(z1, aC, bB); mma64(z2, aS, bA);
          const int ta = tab * 8 + it * 2 + set, m = mb * 32 + r;
#pragma unroll
          for (int reg = 0; reg < 16; ++reg) { const int ka = kab * 32 + ACC_ROW(reg, hi), idx = (ta * ka) & 4095; const float cs = COST[idx], sn = COST[(idx + 3072) & 4095];
              const float re = zr[reg], im = z1[reg] - z2[reg];
              bf16_t* o = FZ + ((((size_t)(b * 4 + g) * 64 + ta) * 64 + ka) * 2) * 64 + m;
              o[0] = (bf16_t)f2bf(re * cs + im * sn); o[64] = (bf16_t)f2bf(im * cs - re * sn); } }
    }
    __syncthreads();
}
__device__ __forceinline__ void fourier_f2(const Params& p, LAS unsigned char* L, int b, int g, int kap) {
    const int tid = tid_opaque(), lane = tid & 63, wave = tid >> 6, r = lane & 31, hi = lane >> 5;
    const bf16_t* FZ = (const bf16_t*)(p.ws + WS_FZ);
    const LAS bf16_t* CM = (const LAS bf16_t*)(L + TAB_OFF); const LAS bf16_t* SM = (const LAS bf16_t*)(L + TAB_OFF + 9216);
#pragma unroll
    for (int j = 0; j < 4; ++j) { const int piece = tid + NTHREADS * j, set = piece >> 10, pp = piece & 1023, ta = pp >> 4, ri = (pp >> 3) & 1, mq = pp & 7, ka = kap * 2 + set;
        const u32x4 v = *(const u32x4*)(FZ + ((((size_t)(b * 4 + g) * 64 + ta) * 64 + ka) * 2 + ri) * 64 + mq * 8);
        LAS bf16_t* ZT = (LAS bf16_t*)(L + set * 18432 + ri * 9216);
#pragma unroll
        for (int i = 0; i < 8; ++i) ZT[(mq * 8 + i) * 72 + ta] = (bf16_t)((i & 1) ? (v[i >> 1] >> 16) : (v[i >> 1] & 0xffffu)); }
    __syncthreads();
    { const int set = wave >> 2, wl = wave & 3, kbb = wl & 1, mb = wl >> 1, ka = kap * 2 + set;
      const LAS bf16_t* ZR = (const LAS bf16_t*)(L + set * 18432); const LAS bf16_t* ZI = ZR + 4608;
      f32x16 acc = ZERO16;
      mma64(acc, CM + (kbb * 32 + r) * 72 + 8 * hi, ZR + (mb * 32 + r) * 72 + 8 * hi); mma64(acc, SM + (kbb * 32 + r) * 72 + 8 * hi, ZI + (mb * 32 + r) * 72 + 8 * hi);
      bf16_t* Y = (bf16_t*)(p.ws + WS_HY);
#pragma unroll
      for (int reg = 0; reg < 16; ++reg) { const int kb = kbb * 32 + ACC_ROW(reg, hi); Y[(size_t)(b * 4096 + ka + 64 * kb) * D + 512 + g * 64 + mb * 32 + r] = (bf16_t)f2bf(acc[reg] * (1.f / 512.f)); } }
    __syncthreads();
}
__device__ __forceinline__ void fourier_ctx(const Params& p, LAS unsigned char* L, int b, int g, int mq) {
    const int tid = tid_opaque();
    const bf16_t* Z = (const bf16_t*)(p.ws + WS_A);
    LAS bf16_t* XC = (LAS bf16_t*)L; LAS float* AC = (LAS float*)(L + 32768); LAS float* BC = (LAS float*)(L + 49152); const LAS float* COST = (const LAS float*)(L + TAB_OFF + 18432);
#pragma unroll
    for (int j = 0; j < 4; ++j) { const int piece = tid + NTHREADS * j, t = piece >> 3, cq = piece & 7;
        *(LAS u32x4*)(XC + t * 64 + cq * 8) = *(const u32x4*)(Z + (size_t)(NLAT + b * 256 + t) * NIN + OFF_F + g * 64 + cq * 8); }
    __syncthreads();
    const int mi = tid & 15, m = mq * 16 + mi, t0 = tid >> 4;
    for (int j = 0; j < 8; ++j) { const int t = t0 + 32 * j; float a = 0.f, bi = 0.f;
        for (int c = 0; c < 64; ++c) { const float x = bf1(XC[t * 64 + c]); const int idx = ((m * c) & 63) * 64; a += x * COST[idx]; bi -= x * COST[(idx + 3072) & 4095]; }
        AC[t * 16 + mi] = a; BC[t * 16 + mi] = bi; }
    __syncthreads();
    float acc[8];
#pragma unroll
    for (int j = 0; j < 8; ++j) acc[j] = 0.f;
    for (int t = 0; t < 256; ++t) { const float a = AC[t * 16 + mi], bi = BC[t * 16 + mi];
#pragma unroll
        for (int j = 0; j < 8; ++j) { const int k = t0 + 32 * j, idx = ((k * t) & 255) * 16; acc[j] += COST[idx] * a + COST[(idx + 3072) & 4095] * bi; } }
    bf16_t* Y = (bf16_t*)(p.ws + WS_HY);
#pragma unroll
    for (int j = 0; j < 8; ++j) { const int k = t0 + 32 * j; Y[(size_t)(NLAT + b * 256 + k) * D + 512 + g * 64 + m] = (bf16_t)f2bf(acc[j] * (1.f / 128.f)); }
    __syncthreads();
}

#define RLX_AGENT __ATOMIC_RELAXED, __HIP_MEMORY_SCOPE_AGENT
#define XB_TMO      128
#define XB_XCNT(j)  (256  + 64 * (j))
#define XB_XSUB(j)  (1280 + 64 * (j))
#define XB_XGEN(j)  (2304 + 64 * (j))
#define XB_TOP      3328
#define XB_TOPGEN   3392
#define XCD_BAR_WORDS 3456
#define XB_SPIN_CAP (1u << 18)

__device__ __forceinline__ unsigned xb_ld(unsigned* p)              { return __hip_atomic_load(p, __ATOMIC_RELAXED, __HIP_MEMORY_SCOPE_AGENT); }
__device__ __forceinline__ unsigned xb_add(unsigned* p, unsigned v) { return __hip_atomic_fetch_add(p, v, __ATOMIC_RELAXED, __HIP_MEMORY_SCOPE_AGENT); }
__device__ __forceinline__ unsigned xb_xcc_id() { return (unsigned)__builtin_amdgcn_s_getreg((3 << 11) | 20) & 0xFu; }
#define XB_SPIN(cond, bar) do { unsigned _sp = 0; while (cond) { __builtin_amdgcn_s_sleep(1); \
    if ((++_sp & 255u) == 0u) { if (xb_ld(&(bar)[XB_TMO])) break; if (_sp > XB_SPIN_CAP) { atomicAdd(&(bar)[XB_TMO], 1u); break; } } } } while (0)

struct XcdBarrier {
    unsigned* bar; unsigned x;
    volatile LAS unsigned* st;
};

__device__ __forceinline__ XcdBarrier xcd_barrier_post(unsigned* bar, volatile LAS unsigned* st) {
    XcdBarrier b; b.bar = bar; b.x = xb_xcc_id(); b.st = st;
    if (threadIdx.x == 0) (void)xb_add(&bar[XB_XCNT(b.x)], 1u);
    return b;
}
__device__ __forceinline__ void xcd_barrier_complete(unsigned* bar, unsigned x, unsigned& nloc, unsigned& nx) {
    const unsigned G = gridDim.x * gridDim.y * gridDim.z;
    unsigned sum, cnt, mine, sp = 0u;
    for (;;) {
        sum = 0u; cnt = 0u; mine = 0u;
#pragma unroll
        for (unsigned j = 0; j < 16; ++j) { const unsigned c = xb_ld(&bar[XB_XCNT(j)]); sum += c; cnt += (c > 0u) ? 1u : 0u; mine = (j == x) ? c : mine; }
        if (sum == G) break;
        __builtin_amdgcn_s_sleep(1);
        if ((++sp & 255u) == 0u) { if (xb_ld(&bar[XB_TMO])) break; if (sp > XB_SPIN_CAP) { atomicAdd(&bar[XB_TMO], 1u); break; } }
    }
    nloc = mine > 0u ? mine : 1u; nx = cnt > 0u ? cnt : 1u;
}

__device__ __forceinline__ void xcd_barrier(const XcdBarrier& b) {
    asm volatile("s_waitcnt vmcnt(0)" ::: "memory");
    __syncthreads();
    if (threadIdx.x == 0) {
        unsigned* bar = b.bar;
        __builtin_amdgcn_s_waitcnt(0);
        unsigned nloc = b.st[0], nx = b.st[1];
        if (nloc == 0u) { xcd_barrier_complete(bar, b.x, nloc, nx); b.st[0] = nloc; b.st[1] = nx; }
        const unsigned old = xb_add(&bar[XB_XSUB(b.x)], 1u);
        const unsigned gen = old / nloc;
        if (old + 1u == (gen + 1u) * nloc) {
            __builtin_amdgcn_fence(__ATOMIC_RELEASE, "agent");
            asm volatile("s_waitcnt vmcnt(0)" ::: "memory");
            const unsigned og = xb_add(&bar[XB_TOP], 1u);
            const unsigned tg = og / nx;
            if (og + 1u == (tg + 1u) * nx) xb_add(&bar[XB_TOPGEN], 1u);
            else XB_SPIN(xb_ld(&bar[XB_TOPGEN]) == tg, bar);
            __builtin_amdgcn_fence(__ATOMIC_ACQUIRE, "agent");
            xb_add(&bar[XB_XGEN(b.x)], 1u);
            asm volatile("s_waitcnt vmcnt(0)" ::: "memory");
        } else {
            XB_SPIN(xb_ld(&bar[XB_XGEN(b.x)]) == gen, bar);
            __builtin_amdgcn_fence(__ATOMIC_ACQUIRE, "agent");
            asm volatile("s_waitcnt vmcnt(0)" ::: "memory");
        }
    }
    __syncthreads();
}
constexpr int NPHASES = 2 + 9 * DEPTH;
#ifndef PROBE_DUP
#define PROBE_DUP 0
#endif
__global__ void __launch_bounds__(NTHREADS, 2) mega_fwd(Params p) {
    extern __shared__ __attribute__((aligned(16))) unsigned char lds_raw[];
    LAS unsigned char* L = (LAS unsigned char*)lds_raw;
    cg::grid_group grid = cg::this_grid();
    if (threadIdx.x < 64) ((volatile LAS unsigned*)(L + MISC_OFF))[threadIdx.x] = 0u;
    __syncthreads();
    XcdBarrier xbar = xcd_barrier_post((unsigned*)(p.ws + WS_CTL), (volatile LAS unsigned*)(L + MISC_OFF));
    unsigned char* ws = p.ws;
    const float* MOD = (const float*)(ws + WS_MOD);
    const int G = gridDim.x, bx = blockIdx.x;
    for (int ph = p.ph_lo; ph < p.ph_hi; ++ph) {
        if (ph == 0) { phase_prologue(p, L); if (PROBE_DUP & 64) { __syncthreads(); phase_prologue(p, L); } }
        else if (ph != 1) {
            const int l = (ph - 2) / 9, sub = (ph - 2) % 9; const bool last = (l == DEPTH - 1);
            const int mrows = last ? NLAT : MROWS, nchunk = last ? 512 : NCHUNK;
            const float* modl = MOD + (size_t)l * 9 * 6144;
            const float* xlat = (l == 0) ? p.in[I_X] : p.out; const float* xctx = (l == 0) ? p.in[I_CTX] : (const float*)(ws + WS_XC);
            const int dupbit = (sub == 0) ? 1 : (sub == 4) ? 2 : (sub == 6) ? 4 : (sub == 7) ? 8 : (sub == 1) ? 16 : (sub == 3) ? 32 : 0;
            for (int rep = 0; rep < ((PROBE_DUP & dupbit) ? 2 : 1); ++rep)
            switch (sub) {
            case 0: { pg8::Gemm g{(const bf16_t*)(ws + WS_HY), (const bf16_t*)(ws + WS_WIN) + (size_t)l * NINP * D, MROWS, NINP, D}; pg8::StaticOrder S; S.init(MROWS, NINP, G, bx);
                      pg8::EpiBf16N E{(bf16_t*)(ws + WS_A), NIN, NIN}; pg8::gemm_phase<pg8::EpiBf16N, pg8::StaticOrder, true, true>(L, g, S, E); } break;
            case 1: { fourier_tables(L);
                      for (int j = bx; j < 256; j += G) fourier_f1(p, L, j >> 5, (j >> 3) & 3, j & 7);
                      if (!last) for (int j = (bx + 128) % G; j < 128; j += G) fourier_ctx(p, L, j >> 4, (j >> 2) & 3, j & 3);
                      gla_g1_loop(p, L, l, bx, G, NCHUNK * 4);
                      rg_loop<false>(p, L, l, (bx + 128) % G, G, NCHUNK * 4); } break;
            case 2: { fourier_tables(L);
                      for (int j = bx; j < 256; j += G) gla_g2(p, j);
                      for (int j = bx; j < 8; j += G) rg_r2(p, j);
                      for (int j = bx; j < 1024; j += G) fourier_f2(p, L, j >> 7, (j >> 5) & 3, j & 31); } break;
            case 3: { const int nG = nchunk * 4;
                      gla_g3_loop(p, L, l, bx, G, nG);
                      rg_loop<true>(p, L, l, (bx + 128) % G, G, nG); } break;
            case 4: { pg8::Gemm g{(const bf16_t*)(ws + WS_HY), (const bf16_t*)(ws + WS_WOUT) + (size_t)l * D * D, mrows, D, D}; pg8::StaticOrder S; S.init(mrows, D, G, bx);
                      pg8::EpiF32 E{(float*)(ws + WS_B), D}; pg8::gemm_phase<pg8::EpiF32, pg8::StaticOrder, true, true>(L, g, S, E); } break;
            case 5: break;
            case 6: { pg8::Gemm g{(const bf16_t*)(ws + WS_HY), (const bf16_t*)(ws + WS_WGU) + (size_t)l * 2 * DFF * D, mrows, 2 * DFF, D}; pg8::StaticOrder S; S.init(mrows, 2 * DFF, G, bx);
                      pg8::EpiSwiGLU E{(bf16_t*)(ws + WS_A), DFF}; pg8::gemm_phase<pg8::EpiSwiGLU, pg8::StaticOrder, true, true>(L, g, S, E); } break;
            case 7: { pg8::Gemm g{(const bf16_t*)(ws + WS_A), (const bf16_t*)(ws + WS_WDN) + (size_t)l * D * DFF, mrows, D, DFF}; pg8::StaticOrder S; S.init(mrows, D, G, bx);
                      pg8::EpiF32 E{(float*)(ws + WS_B), D}; pg8::gemm_phase<pg8::EpiF32, pg8::StaticOrder, true, true>(L, g, S, E); } break;
            default: break;
            }
        }
        {
            const int l = (ph < 2) ? 0 : (ph - 2) / 9, sub = (ph < 2) ? -1 : (ph - 2) % 9; const bool last = (l == DEPTH - 1);
            if (ph == 1 || sub == 5 || sub == 8) {
                const bool has_t = (ph != 1), r2 = (sub == 8);
                const float* modl = MOD + (size_t)l * 9 * 6144;
                const float* xlat = (l == 0 && !r2) ? p.in[I_X] : p.out; const float* xctx = (l == 0 && !r2) ? p.in[I_CTX] : (const float*)(ws + WS_XC);
                const int lh = r2 ? (last ? l : l + 1) : l;
                rows_phase(p, has_t, (last && has_t) ? NLAT : MROWS, xlat, xctx, (const float*)(ws + WS_B), p.in[r2 ? I_GPOSTFFN : I_GPOSTMIX] + l * D, modl, r2 ? 5120 : 2048,
                           !(r2 && last), p.in[(sub == 5) ? I_GPREFFN : I_GPREMIX] + lh * D, MOD + (size_t)lh * 9 * 6144, (sub == 5) ? 3072 : 0, (sub == 5) ? 4096 : 1024);
            }
        }
        if (ph + 1 < p.ph_hi) { if (ph == 0) grid.sync(); else xcd_barrier(xbar); }
    }
}

#ifndef MK_SPLIT
#define MK_SPLIT 0
#endif
extern "C" void kernel_launch(void* const* d_in, const int* in_sizes, int n_in, void* d_out, int out_size, void* d_ws, size_t ws_size, hipStream_t stream) {
    static int grid = 0;
    if (grid == 0) {
        int dev = 0, cus = 0, per_cu = 0;
        if (n_in != 25 || ws_size < WS_CTL + CTL_BYTES) { fprintf(stderr, "kernel_launch: unexpected inputs (n_in %d, ws %zu)\n", n_in, ws_size); grid = -1; return; }
        hipGetDevice(&dev); hipDeviceGetAttribute(&cus, hipDeviceAttributeMultiprocessorCount, dev);
        if (hipFuncSetAttribute((const void*)mega_fwd, hipFuncAttributeMaxDynamicSharedMemorySize, LDS_BYTES) != hipSuccess) fprintf(stderr, "kernel_launch: hipFuncSetAttribute failed\n");
        if (hipOccupancyMaxActiveBlocksPerMultiprocessor(&per_cu, (const void*)mega_fwd, NTHREADS, LDS_BYTES) != hipSuccess || per_cu < 1) { fprintf(stderr, "kernel_launch: occupancy query gave %d\n", per_cu); per_cu = 1; }
        (void)hipGetLastError();
        grid = cus * 1;
    }
    if (grid < 0) return;
    if (hipMemsetAsync((char*)d_ws + WS_CTL, 0, CTL_BYTES, stream) != hipSuccess) fprintf(stderr, "kernel_launch: memset failed\n");
    Params p{};
    for (int i = 0; i < 25; ++i) p.in[i] = (const float*)d_in[i];
    p.out = (float*)d_out; p.ws = (unsigned char*)d_ws;
#if MK_SPLIT
    for (int ph = 0; ph < NPHASES; ++ph) { p.ph_lo = ph; p.ph_hi = ph + 1; hipLaunchKernelGGL(mega_fwd, dim3(grid), dim3(NTHREADS), LDS_BYTES, stream, p); }
#else
    p.ph_lo = 0; p.ph_hi = NPHASES;
    void* args[] = {&p};
    hipError_t e = hipLaunchCooperativeKernel((const void*)mega_fwd, dim3(grid), dim3(NTHREADS), args, LDS_BYTES, stream);
    if (e != hipSuccess) fprintf(stderr, "kernel_launch: cooperative launch failed: %s (grid %d)\n", hipGetErrorString(e), grid);
#endif
}
```

```cpp
#include <hip/hip_runtime.h>
#include <hip/hip_cooperative_groups.h>
#include <cstdio>
#include <cstdint>
namespace cg = cooperative_groups;
namespace pg8 {
#define PG8_LAS __attribute__((address_space(3)))
typedef unsigned short bf16_t;
typedef short bf16x8 __attribute__((ext_vector_type(8)));
typedef float f32x4 __attribute__((ext_vector_type(4)));
typedef unsigned u32x4 __attribute__((ext_vector_type(4)));
constexpr int BM = 256, BK = 64, HALF = 128, HTB = HALF * BK * 2  , STAGE_BYTES = 8 * HTB, NXCD = 8, WGM = 8;

__host__ __device__ __forceinline__ int lds_byte(int r, int c) { const int st = (r >> 4) * 2 + (c >> 5), rr = r & 15, cc = c & 31, ob = rr * 64 + cc * 2; return st * 1024 + (ob ^ (((ob >> 9) & 1) << 5)); }
__host__ __device__ __forceinline__ void stage_rc(int b, int& R, int& C) { const int st = b / 1024, sb = b % 1024, swz = sb ^ (((sb >> 9) & 1) << 5); R = (st >> 1) * 16 + swz / 64; C = (st & 1) * 32 + (swz % 64) / 2; }
__host__ __device__ __forceinline__ int perm32(int rho) { const int n = rho >> 4, i = rho & 15; return 8 * (i >> 2) + 4 * n + (i & 3); }

struct Unit { int pm, pn; };
struct Gemm { const bf16_t* A; const bf16_t* Bt; int M, N, K; };

struct StaticOrder {
    int nM, nN, nwg, G, c;
    __host__ __device__ void init(int M, int N, int G_, int c_) { nM = M / BM; nN = N / BM; nwg = nM * nN; G = G_; c = c_; }
    __host__ __device__ bool next(int i, Unit& u) const {
        const long L = (long)i * G + c; if (L >= nwg) return false;
        int wgid = (int)L; { const int q = nwg / NXCD, r = nwg % NXCD, xcd = wgid % NXCD, off = wgid / NXCD; wgid = (xcd < r ? xcd * (q + 1) : r * (q + 1) + (xcd - r) * q) + off; }
        const int nig = WGM * nN, gid = wgid / nig, fm = gid * WGM, gsz = (nM - fm) < WGM ? (nM - fm) : WGM;
        u.pm = fm + ((wgid % nig) % gsz); u.pn = (wgid % nig) / gsz; return true;
    }
    __device__ __forceinline__ void a_ready(const Unit&) const {}
    __device__ __forceinline__ void done(const Unit&) const {}
};

__device__ __forceinline__ unsigned cvt_pk_bf16(float lo, float hi) { unsigned r; asm volatile("v_cvt_pk_bf16_f32 %0, %1, %2" : "=v"(r) : "v"(lo), "v"(hi)); return r; }
typedef float f32x2 __attribute__((ext_vector_type(2)));
struct EpiBf16N {
    static constexpr bool PERM = true, AFTER_DRAIN = false;
    bf16_t* O; int ldc; int nvalid;
    __device__ __forceinline__ void operator()(const f32x4 (&acc)[2][2][4][2], const Unit& u, int wr, int wc, int fr, int fq) const {
        const int row0 = u.pm * BM + wr * 64 + fr, col0 = u.pn * BM + wc * 32 + 8 * fq;
#pragma unroll
        for (int ai = 0; ai < 2; ++ai)
#pragma unroll
            for (int m = 0; m < 4; ++m) { bf16_t* rowp = O + (size_t)(row0 + ai * HALF + m * 16) * ldc;
#pragma unroll
                for (int bj = 0; bj < 2; ++bj) { const int c = col0 + bj * HALF; const f32x4 v0 = acc[ai][bj][m][0], v1 = acc[ai][bj][m][1];
                    u32x4 w; w.x = cvt_pk_bf16(v0[0], v0[1]); w.y = cvt_pk_bf16(v0[2], v0[3]); w.z = cvt_pk_bf16(v1[0], v1[1]); w.w = cvt_pk_bf16(v1[2], v1[3]);
                    if (c < nvalid) *(u32x4*)(rowp + c) = w; } }
    }
};
struct EpiF32 {
    static constexpr bool PERM = true, AFTER_DRAIN = false;
    float* O; int ldc;
    __device__ __forceinline__ void operator()(const f32x4 (&acc)[2][2][4][2], const Unit& u, int wr, int wc, int fr, int fq) const {
        const int row0 = u.pm * BM + wr * 64 + fr, col0 = u.pn * BM + wc * 32 + 8 * fq;
#pragma unroll
        for (int ai = 0; ai < 2; ++ai)
#pragma unroll
            for (int m = 0; m < 4; ++m) { float* rowp = O + (size_t)(row0 + ai * HALF + m * 16) * ldc + col0;
#pragma unroll
                for (int bj = 0; bj < 2; ++bj) { *(f32x4*)(rowp + bj * HALF) = acc[ai][bj][m][0]; *(f32x4*)(rowp + bj * HALF + 4) = acc[ai][bj][m][1]; } }
    }
};
struct EpiSwiGLU {
    static constexpr bool PERM = true, AFTER_DRAIN = false;
    bf16_t* O; int ldc;
    __device__ __forceinline__ void operator()(const f32x4 (&acc)[2][2][4][2], const Unit& u, int wr, int wc, int fr, int fq) const {
        const int row0 = u.pm * BM + wr * 64 + fr, col0 = u.pn * HALF + wc * 32 + 8 * fq;
#pragma unroll
        for (int ai = 0; ai < 2; ++ai)
#pragma unroll
            for (int m = 0; m < 4; ++m) { bf16_t* rowp = O + (size_t)(row0 + ai * HALF + m * 16) * ldc + col0;
                float h[8];
#pragma unroll
                for (int n = 0; n < 2; ++n)
#pragma unroll
                    for (int j = 0; j < 4; ++j) { const float g = acc[ai][0][m][n][j], up = acc[ai][1][m][n][j]; h[n * 4 + j] = g * __builtin_amdgcn_rcpf(1.f + __expf(-g)) * up; }
                u32x4 w; w.x = cvt_pk_bf16(h[0], h[1]); w.y = cvt_pk_bf16(h[2], h[3]); w.z = cvt_pk_bf16(h[4], h[5]); w.w = cvt_pk_bf16(h[6], h[7]);
                *(u32x4*)rowp = w; }
    }
};
template <class Epi, class Sched, bool ALIGN_EPI = false, bool SP2 = false>
__device__ __forceinline__ void gemm_phase(PG8_LAS unsigned char* lds, const Gemm g, const Sched& S, const Epi& E) {
    int tid = threadIdx.x; asm volatile("" : "+v"(tid)); const int wid = __builtin_amdgcn_readfirstlane(tid >> 6), lane = tid & 63, wr = wid >> 2, wc = wid & 3, fr = lane & 15, fq = lane >> 4;
    const int K = g.K, nt = K / BK;
    unsigned voffA[2], voffB[2];
#pragma unroll
    for (int i = 0; i < 2; ++i) { int R, C; stage_rc(tid * 16 + i * 8192, R, C); const int Rb = Epi::PERM ? ((R & ~31) + perm32(R & 31)) : R;
        voffA[i] = (unsigned)(R * K + C) * 2u; voffB[i] = (unsigned)(Rb * K + C) * 2u; }
    const size_t kstep = (size_t)(BK * 2);
    const size_t hstep = (size_t)HALF * K * 2;
    const size_t tstep = 2 * hstep;
    const unsigned ldsw = (unsigned)wid * 1024u;
    const int aoff = lds_byte(wr * 64 + fr, fq * 8), boff = lds_byte(wc * 32 + fr, fq * 8);
#define PG8_SA(b, h) (((b) * 2 + (h)) * HTB)
#define PG8_SB(b, h) ((4 + (b) * 2 + (h)) * HTB)
#define PG8_STAGE(bufoff, gbase, voff) do { _Pragma("unroll") for (int _i = 0; _i < 2; ++_i) \
        __builtin_amdgcn_global_load_lds((const unsigned*)((const char*)(gbase) + (voff)[_i]), (PG8_LAS unsigned*)(lds + (bufoff) + ldsw + _i * 8192), 16, 0, 0); } while (0)
#define PG8_LDA(dst, b, h) do { _Pragma("unroll") for (int m = 0; m < 4; ++m) _Pragma("unroll") for (int k = 0; k < 2; ++k) dst[m][k] = *(const PG8_LAS bf16x8*)(lds + PG8_SA(b, h) + aoff + m * 2048 + k * 1024); } while (0)
#define PG8_LDB(dst, b, h) do { _Pragma("unroll") for (int n = 0; n < 2; ++n) _Pragma("unroll") for (int k = 0; k < 2; ++k) dst[n][k] = *(const PG8_LAS bf16x8*)(lds + PG8_SB(b, h) + boff + n * 2048 + k * 1024); } while (0)
#define PG8_MMA(ai, bj, At, Bt) do { __builtin_amdgcn_s_setprio(1); _Pragma("unroll") for (int m = 0; m < 4; ++m) _Pragma("unroll") for (int n = 0; n < 2; ++n) _Pragma("unroll") for (int k = 0; k < 2; ++k) \
        acc[ai][bj][m][n] = __builtin_amdgcn_mfma_f32_16x16x32_bf16(Bt[n][k], At[m][k], acc[ai][bj][m][n], 0, 0, 0); __builtin_amdgcn_s_setprio(0); } while (0)
#define PG8_WAIT_V(n) asm volatile("s_waitcnt vmcnt(" #n ")" ::: "memory")
#define PG8_WAIT_L(n) asm volatile("s_waitcnt lgkmcnt(" #n ")" ::: "memory")
#define PG8_BAR __builtin_amdgcn_s_barrier()
#define PG8_SCHED __builtin_amdgcn_sched_barrier(0)
    Unit cur, nxt; int ui = 0;
    if (!S.next(0, cur)) return;
    f32x4 acc[2][2][4][2];
#pragma unroll
    for (int a = 0; a < 2; ++a)
#pragma unroll
        for (int b = 0; b < 2; ++b)
#pragma unroll
            for (int m = 0; m < 4; ++m)
#pragma unroll
                for (int n = 0; n < 2; ++n) acc[a][b][m][n] = (f32x4){0.f, 0.f, 0.f, 0.f};
    bf16x8 At[4][2], B0[2][2], B1[2][2];
    const char* cA = (const char*)g.A + (size_t)cur.pm * tstep; const char* cB = (const char*)g.Bt + (size_t)cur.pn * tstep;
    S.a_ready(cur);
    if constexpr (SP2) {
        PG8_STAGE(PG8_SB(0, 0), cB, voffB); PG8_STAGE(PG8_SB(0, 1), cB + hstep, voffB); PG8_STAGE(PG8_SA(0, 0), cA, voffA); PG8_STAGE(PG8_SA(0, 1), cA + hstep, voffA);
        if (wr == 1) PG8_BAR;
        PG8_WAIT_V(2); PG8_BAR;
        PG8_STAGE(PG8_SB(1, 0), cB + kstep, voffB); PG8_STAGE(PG8_SA(1, 0), cA + kstep, voffA); PG8_STAGE(PG8_SB(1, 1), cB + hstep + kstep, voffB);
        PG8_WAIT_V(6); PG8_BAR;
    } else {
        PG8_STAGE(PG8_SB(0, 0), cB, voffB); PG8_STAGE(PG8_SA(0, 0), cA, voffA); PG8_STAGE(PG8_SB(0, 1), cB + hstep, voffB); PG8_STAGE(PG8_SA(0, 1), cA + hstep, voffA);
        if (wr == 1) PG8_BAR;
        PG8_WAIT_V(4); PG8_BAR;
        PG8_STAGE(PG8_SB(1, 0), cB + kstep, voffB); PG8_STAGE(PG8_SA(1, 0), cA + kstep, voffA); PG8_STAGE(PG8_SB(1, 1), cB + hstep + kstep, voffB);
        PG8_WAIT_V(6); PG8_BAR;
    }
    for (;;) {
        const bool has_next = S.next(ui + 1, nxt);
        const char* nA = has_next ? (const char*)g.A + (size_t)nxt.pm * tstep : cA; const char* nB = has_next ? (const char*)g.Bt + (size_t)nxt.pn * tstep : cB;
        for (int t = 0; t < nt; t += 2) {
            const bool last = (t == nt - 2);
            const char* a1 = cA + (size_t)(t + 1) * kstep;
            const char* a2 = last ? nA : cA + (size_t)(t + 2) * kstep; const char* b2 = last ? nB : cB + (size_t)(t + 2) * kstep;
            const char* a3 = a2 + kstep; const char* b3 = b2 + kstep;
            if (last && has_next) S.a_ready(nxt);
            if constexpr (SP2) {
            PG8_LDB(B0, 0, 0); PG8_LDB(B1, 0, 1); PG8_SCHED; PG8_LDA(At, 0, 0); PG8_STAGE(PG8_SA(1, 1), a1 + hstep, voffA);
            PG8_WAIT_V(8); PG8_WAIT_L(0); PG8_BAR; PG8_MMA(0, 0, At, B0); PG8_MMA(0, 1, At, B1); PG8_BAR; PG8_SCHED;
            PG8_LDA(At, 0, 1); PG8_STAGE(PG8_SB(0, 0), b2, voffB); PG8_STAGE(PG8_SB(0, 1), b2 + hstep, voffB); PG8_STAGE(PG8_SA(0, 0), a2, voffA);
            PG8_WAIT_V(8); PG8_WAIT_L(0); PG8_BAR; PG8_MMA(1, 0, At, B0); PG8_MMA(1, 1, At, B1); PG8_BAR; PG8_SCHED;
            PG8_LDB(B0, 1, 0); PG8_LDB(B1, 1, 1); PG8_SCHED; PG8_LDA(At, 1, 0); PG8_STAGE(PG8_SA(0, 1), a2 + hstep, voffA);
            PG8_WAIT_V(8); PG8_WAIT_L(0); PG8_BAR; PG8_MMA(0, 0, At, B0); PG8_MMA(0, 1, At, B1); PG8_BAR; PG8_SCHED;
            PG8_LDA(At, 1, 1); PG8_STAGE(PG8_SB(1, 0), b3, voffB); PG8_STAGE(PG8_SB(1, 1), b3 + hstep, voffB); PG8_STAGE(PG8_SA(1, 0), a3, voffA);
            PG8_WAIT_V(8); PG8_WAIT_L(0); PG8_BAR; PG8_MMA(1, 0, At, B0); PG8_MMA(1, 1, At, B1); PG8_BAR; PG8_SCHED;
            } else {
            PG8_LDB(B0, 0, 0); PG8_SCHED; PG8_LDA(At, 0, 0); PG8_STAGE(PG8_SA(1, 1), a1 + hstep, voffA);
            PG8_WAIT_L(8); PG8_BAR; PG8_WAIT_L(0); PG8_MMA(0, 0, At, B0); PG8_BAR; PG8_SCHED;
            PG8_LDB(B1, 0, 1); PG8_STAGE(PG8_SB(0, 0), b2, voffB);
            PG8_BAR; PG8_WAIT_L(0); PG8_MMA(0, 1, At, B1); PG8_BAR;
            PG8_LDA(At, 0, 1); PG8_STAGE(PG8_SA(0, 0), a2, voffA);
            PG8_BAR; PG8_WAIT_L(0); PG8_MMA(1, 0, At, B0); PG8_BAR; PG8_SCHED;
            PG8_STAGE(PG8_SB(0, 1), b2 + hstep, voffB);
            PG8_WAIT_V(6); PG8_BAR; PG8_MMA(1, 1, At, B1); PG8_BAR;
            PG8_LDB(B0, 1, 0); PG8_SCHED; PG8_LDA(At, 1, 0); PG8_STAGE(PG8_SA(0, 1), a2 + hstep, voffA);
            PG8_WAIT_L(8); PG8_BAR; PG8_WAIT_L(0); PG8_MMA(0, 0, At, B0); PG8_BAR; PG8_SCHED;
            PG8_LDB(B1, 1, 1); PG8_STAGE(PG8_SB(1, 0), b3, voffB);
            PG8_BAR; PG8_WAIT_L(0); PG8_MMA(0, 1, At, B1); PG8_BAR;
            PG8_LDA(At, 1, 1); PG8_STAGE(PG8_SA(1, 0), a3, voffA);
            PG8_BAR; PG8_WAIT_L(0); PG8_MMA(1, 0, At, B0); PG8_BAR; PG8_SCHED;
            PG8_STAGE(PG8_SB(1, 1), b3 + hstep, voffB);
            PG8_WAIT_V(6); PG8_BAR; PG8_MMA(1, 1, At, B1); PG8_BAR;
            }
        }
        if constexpr (ALIGN_EPI) { if (wr == 0) PG8_BAR; }
        if constexpr (!Epi::AFTER_DRAIN) { E(acc, cur, wr, wc, fr, fq); S.done(cur); }
        if (!has_next) break;
#pragma unroll
        for (int a = 0; a < 2; ++a)
#pragma unroll
            for (int b = 0; b < 2; ++b)
#pragma unroll
                for (int m = 0; m < 4; ++m)
#pragma unroll
                    for (int n = 0; n < 2; ++n) acc[a][b][m][n] = (f32x4){0.f, 0.f, 0.f, 0.f};
        cur = nxt; cA = nA; cB = nB; ++ui;
        if constexpr (ALIGN_EPI) { if (wr == 1) PG8_BAR; }
    }
    PG8_WAIT_V(0);
    if constexpr (!ALIGN_EPI) { if (wr == 0) PG8_BAR; }
    PG8_BAR;
    if constexpr (Epi::AFTER_DRAIN) { E.fused(acc, cur, wr, wc, fr, fq, lds, wid, lane); S.done(cur); }
#undef PG8_SA
#undef PG8_SB
#undef PG8_STAGE
#undef PG8_LDA
#undef PG8_LDB
#undef PG8_MMA
#undef PG8_WAIT_V
#undef PG8_WAIT_L
#undef PG8_BAR
#undef PG8_SCHED
}
}
#define LAS __attribute__((address_space(3)))
typedef unsigned short bf16_t;
typedef short bf16x8 __attribute__((ext_vector_type(8)));
typedef float f32x4 __attribute__((ext_vector_type(4)));
typedef float f32x16 __attribute__((ext_vector_type(16)));
typedef unsigned u32x4 __attribute__((ext_vector_type(4)));
typedef unsigned u32x2 __attribute__((ext_vector_type(2)));

constexpr int D = 1024, NB = 8, SEQ = 4096, CTX = 256, DEPTH = 4;
constexpr int NLAT = NB * SEQ, NCTX = NB * CTX, MROWS = NLAT + NCTX;
constexpr int NIN = 2336, NINP = 2560, DFF = 2816;
constexpr int OFF_Q = 0, OFF_K = 256, OFF_V = 512, OFF_DEC = 1024, OFF_OG = 1056, OFF_F = 1568, OFF_RX = 1824, OFF_RG = 2080;
constexpr int NCHUNK = MROWS / 64;
constexpr float EPS = 1e-6f;
constexpr int NTHREADS = 512, NWAVES = 8;
constexpr int LDS_BYTES = 147456 + 256;
constexpr int MISC_OFF = 147456;
constexpr int TAB_OFF = 147456 - 34816;

constexpr size_t MiB = 1u << 20;
constexpr size_t WS_WIN = 0, WS_WOUT = 20 * MiB, WS_WGU = 28 * MiB, WS_WDN = 72 * MiB, WS_MOD = 94 * MiB, WS_WRG = 95 * MiB, WS_DEC = 96 * MiB,
                 WS_RGS = 98 * MiB, WS_HST = 101 * MiB, WS_XC = 103 * MiB, WS_HY = 111 * MiB, WS_A = 179 * MiB, WS_B = 366 * MiB, WS_FZ = 434 * MiB, WS_END = 502 * MiB, WS_CTL = 510 * MiB, CTL_BYTES = 16384;

struct Params { const float* in[25]; float* out; unsigned char* ws; int ph_lo, ph_hi; };
enum { I_X = 0, I_C, I_CTX, I_CCTX, I_WADA, I_BADA, I_GPREMIX, I_GPOSTMIX, I_GPREFFN, I_GPOSTFFN, I_WIN, I_WDEC, I_BDEC, I_GGLA, I_WCONV, I_BCONV,
       I_WRGA, I_BRGA, I_WRGX, I_BRGX, I_RGLAM, I_WOUT, I_WGATE, I_WUP, I_WDOWN };

__device__ __forceinline__ int tid_opaque() { int t = threadIdx.x; asm volatile("" : "+v"(t)); return t; }
typedef __bf16 bf16x2_t __attribute__((ext_vector_type(2)));
typedef float f32x2_t __attribute__((ext_vector_type(2)));
__device__ __forceinline__ unsigned pk2(float lo, float hi) { const f32x2_t v = {lo, hi}; const bf16x2_t b = __builtin_convertvector(v, bf16x2_t); return __builtin_bit_cast(unsigned, b); }
__device__ __forceinline__ unsigned f2bf(float f) { return pk2(f, 0.f) & 0xffffu; }
__device__ __forceinline__ float bflo(unsigned w) { return __builtin_bit_cast(float, w << 16); }
__device__ __forceinline__ float bfhi(unsigned w) { return __builtin_bit_cast(float, w & 0xffff0000u); }
__device__ __forceinline__ float bf1(unsigned short h) { return __builtin_bit_cast(float, (unsigned)h << 16); }
#define BFE(v, i) (((i) & 1) ? bfhi((v)[(i) >> 1]) : bflo((v)[(i) >> 1]))
__device__ __forceinline__ float wave_sum(float v) {
#pragma unroll
    for (int o = 1; o < 64; o <<= 1) v += __shfl_xor(v, o);
    return v;
}
__device__ __forceinline__ float sigmoidf_(float x) { return __builtin_amdgcn_rcpf(1.f + __expf(-x)); }
__device__ __forceinline__ bf16x8 ldv(const LAS bf16_t* p) { return *(const LAS bf16x8*)p; }
__device__ __forceinline__ bf16x8 ldv(const bf16_t* p) { return *(const bf16x8*)p; }
template <class PA, class PB> __device__ __forceinline__ void mma64(f32x16& acc, PA a, PB b) {
#pragma unroll
    for (int k0 = 0; k0 < 64; k0 += 16) acc = __builtin_amdgcn_mfma_f32_32x32x16_bf16(ldv(a + k0), ldv(b + k0), acc, 0, 0, 0);
}
typedef short v4i16_t __attribute__((ext_vector_type(4)));
__device__ __forceinline__ bf16x8 ldtr(const LAS bf16_t* tile, int ld, int k0, int n0, int lane) {
    const int i = lane & 15, hi = lane >> 5, gh = (lane >> 4) & 1;
    const LAS bf16_t* q = tile + (k0 + 8 * hi + (i >> 2)) * ld + n0 + 16 * gh + 4 * (i & 3);
    const v4i16_t a = __builtin_amdgcn_ds_read_tr16_b64_v4i16((LAS v4i16_t*)q);
    const v4i16_t b = __builtin_amdgcn_ds_read_tr16_b64_v4i16((LAS v4i16_t*)(q + 4 * ld));
    return (bf16x8){a[0], a[1], a[2], a[3], b[0], b[1], b[2], b[3]};
}
__device__ __forceinline__ void mma64_tt(f32x16& acc, const LAS bf16_t* ta, int lda, int m0, const LAS bf16_t* tb, int ldb, int n0, int lane) {
#pragma unroll
    for (int k0 = 0; k0 < 64; k0 += 16) acc = __builtin_amdgcn_mfma_f32_32x32x16_bf16(ldtr(ta, lda, k0, m0, lane), ldtr(tb, ldb, k0, n0, lane), acc, 0, 0, 0);
}
template <class PA> __device__ __forceinline__ void mma64_rt(f32x16& acc, PA a, const LAS bf16_t* tb, int ldb, int n0, int lane) {
#pragma unroll
    for (int k0 = 0; k0 < 64; k0 += 16) acc = __builtin_amdgcn_mfma_f32_32x32x16_bf16(ldv(a + k0), ldtr(tb, ldb, k0, n0, lane), acc, 0, 0, 0);
}
#define ACC_ROW(reg, hi) (((reg) & 3) + 8 * ((reg) >> 2) + 4 * (hi))
#define ZERO16 ((f32x16){0.f,0.f,0.f,0.f,0.f,0.f,0.f,0.f,0.f,0.f,0.f,0.f,0.f,0.f,0.f,0.f})

__device__ __forceinline__ void transpose_item(const float* W, int N, bf16_t* WT, int ldk, int k0, int n0, int drow0, LAS float* scr, int lane) {
#pragma unroll 8
    for (int i = 0; i < 32; ++i) { const int kk = 2 * i + (lane >> 5); scr[kk * 33 + (lane & 31)] = W[(size_t)(k0 + kk) * N + n0 + (lane & 31)]; }
    asm volatile("s_waitcnt lgkmcnt(0)" ::: "memory");
    const int c = lane & 7;
#pragma unroll
    for (int j = 0; j < 4; ++j) { const int n = (lane >> 3) + 8 * j; const LAS float* s = scr + (8 * c) * 33 + n;
        u32x4 o; o.x = pk2(s[0 * 33], s[1 * 33]); o.y = pk2(s[2 * 33], s[3 * 33]); o.z = pk2(s[4 * 33], s[5 * 33]); o.w = pk2(s[6 * 33], s[7 * 33]);
        *(u32x4*)(WT + (size_t)(drow0 + n) * ldk + k0 + 8 * c) = o; }
    asm volatile("s_waitcnt lgkmcnt(0)" ::: "memory");
}

__device__ __forceinline__ void phase_prologue(const Params& p, LAS unsigned char* L) {
    const int tid = tid_opaque(), lane = tid & 63, wave = tid >> 6;
    unsigned char* ws = p.ws;
    {
        LAS float* scr = (LAS float*)(L + wave * 16384);
        const int gw = blockIdx.x * NWAVES + wave, NGW = gridDim.x * NWAVES;
        constexpr int I_IN = 16 * 73, I_OUT = 16 * 32, I_G = 16 * 88, I_DN = 44 * 32, I_L = I_IN + I_OUT + 2 * I_G + I_DN;
        for (int it = gw; it < DEPTH * I_L; it += NGW) {
            const int l = it / I_L; int r = it % I_L;
            if (r < I_IN) { const int kb = r / 73, nb = r % 73; transpose_item(p.in[I_WIN] + (size_t)l * D * NIN, NIN, (bf16_t*)(ws + WS_WIN) + (size_t)l * NINP * D, D, kb * 64, nb * 32, nb * 32, scr, lane); continue; }
            r -= I_IN;
            if (r < I_OUT) { const int kb = r / 32, nb = r % 32; transpose_item(p.in[I_WOUT] + (size_t)l * D * D, D, (bf16_t*)(ws + WS_WOUT) + (size_t)l * D * D, D, kb * 64, nb * 32, nb * 32, scr, lane); continue; }
            r -= I_OUT;
            if (r < 2 * I_G) { const int up = r >= I_G; if (up) r -= I_G; const int kb = r / 88, nb = r % 88, n0 = nb * 32;
                transpose_item(p.in[up ? I_WUP : I_WGATE] + (size_t)l * D * DFF, DFF, (bf16_t*)(ws + WS_WGU) + (size_t)l * 2 * DFF * D, D, kb * 64, n0, 256 * (n0 >> 7) + (n0 & 127) + (up ? 128 : 0), scr, lane); continue; }
            r -= 2 * I_G;
            { const int kb = r / 32, nb = r % 32; transpose_item(p.in[I_WDOWN] + (size_t)l * DFF * D, D, (bf16_t*)(ws + WS_WDN) + (size_t)l * D * DFF, DFF, kb * 64, nb * 32, nb * 32, scr, lane); }
        }
        const int gt = blockIdx.x * NTHREADS + tid, NGT = gridDim.x * NTHREADS;
        constexpr int PADV = (NINP - NIN) * D / 8;
        for (int i = gt; i < DEPTH * PADV; i += NGT) { const int l = i / PADV, q = i % PADV;
            *(u32x4*)((bf16_t*)(ws + WS_WIN) + (size_t)l * NINP * D + (size_t)NIN * D + (size_t)q * 8) = (u32x4){0u, 0u, 0u, 0u}; }
        for (int i = gt; i < DEPTH * 2 * 2 * 4 * 4096; i += NGT) {
            const int in_ = i & 63, out_ = (i >> 6) & 63, head = (i >> 12) & 3, ax = (i >> 14) & 1, dir = (i >> 15) & 1, l = i >> 16;
            const float* W = p.in[ax ? I_WRGX : I_WRGA];
            ((bf16_t*)(ws + WS_WRG))[i] = (bf16_t)f2bf(W[((((size_t)l * 2 + dir) * 4 + head) * 64 + in_) * 64 + out_]);
        }
    }
    __syncthreads();
    {
        LAS float* sl = (LAS float*)L;
        LAS float* red = (LAS float*)(L + 36864);
        for (int i = tid; i < 9 * 1024; i += NTHREADS) { const int r = i >> 10, k = i & 1023; const float v = (r < 8) ? p.in[I_C][r * 1024 + k] : p.in[I_CCTX][k]; sl[i] = v / (1.f + __expf(-v)); }
        __syncthreads();
        float* MOD = (float*)(ws + WS_MOD);
        for (int item = blockIdx.x; item < DEPTH * 96; item += gridDim.x) {
            const int l = item / 96, cb = item % 96, cc = tid & 63, kg = tid >> 6;
            const float* w = p.in[I_WADA] + ((size_t)l * 1024 + kg * 128) * 6144 + cb * 64 + cc;
            float a0 = 0.f, a1 = 0.f, a2 = 0.f, a3 = 0.f, a4 = 0.f, a5 = 0.f, a6 = 0.f, a7 = 0.f, a8 = 0.f;
            const LAS float* s = sl + kg * 128;
#pragma unroll 8
            for (int k = 0; k < 128; ++k) { const float wv = w[(size_t)k * 6144];
                a0 += s[k] * wv; a1 += s[1024 + k] * wv; a2 += s[2048 + k] * wv; a3 += s[3072 + k] * wv; a4 += s[4096 + k] * wv;
                a5 += s[5120 + k] * wv; a6 += s[6144 + k] * wv; a7 += s[7168 + k] * wv; a8 += s[8192 + k] * wv; }
            LAS float* rp = red + kg * 576 + cc;
            rp[0] = a0; rp[64] = a1; rp[128] = a2; rp[192] = a3; rp[256] = a4; rp[320] = a5; rp[384] = a6; rp[448] = a7; rp[512] = a8;
            __syncthreads();
            for (int i = tid; i < 576; i += NTHREADS) { float sum = 0.f;
#pragma unroll
                for (int g = 0; g < 8; ++g) sum += red[g * 576 + i];
                const int r = i >> 6, c2 = i & 63; MOD[((size_t)l * 9 + r) * 6144 + cb * 64 + c2] = sum + p.in[I_BADA][l * 6144 + cb * 64 + c2]; }
            __syncthreads();
        }
    }
}

__device__ __forceinline__ void rows_phase(const Params& p, const bool HAS_T, int nrows, const float* xlat_src, const float* xctx_src, const bf16_t* T, const float* gpost, const float* modT, int gt_off,
                                           bool want_h, const float* gpre, const float* modH, int sh_off, int sc_off) {
    const int tid = tid_opaque(), lane = tid & 63, wave = tid >> 6;
    const int gw = blockIdx.x * NWAVES + wave, NGW = gridDim.x * NWAVES;
    float* xlat_dst = p.out; float* xctx_dst = (float*)(p.ws + WS_XC); bf16_t* H = (bf16_t*)(p.ws + WS_HY);
    for (int row = gw; row < nrows; row += NGW) {
        const bool isctx = row >= NLAT; const int mrow = isctx ? 8 : (row >> 12);
        const float* xs = isctx ? xctx_src + (size_t)(row - NLAT) * D : xlat_src + (size_t)row * D;
        f32x4 x[4];
#pragma unroll
        for (int j = 0; j < 4; ++j) x[j] = *(const f32x4*)(xs + 4 * lane + 256 * j);
        if (HAS_T) {
            f32x4 t[4]; float ss = 0.f;
#pragma unroll
            for (int j = 0; j < 4; ++j) { const u32x2 tv = *(const u32x2*)(T + (size_t)row * D + 4 * lane + 256 * j); t[j] = (f32x4){bflo(tv.x), bfhi(tv.x), bflo(tv.y), bfhi(tv.y)}; ss += t[j].x * t[j].x + t[j].y * t[j].y + t[j].z * t[j].z + t[j].w * t[j].w; }
            const float rstd = rsqrtf(wave_sum(ss) * (1.f / D) + EPS);
            const float* mt = modT + (size_t)mrow * 6144 + gt_off;
            float* xd = isctx ? xctx_dst + (size_t)(row - NLAT) * D : xlat_dst + (size_t)row * D;
#pragma unroll
            for (int j = 0; j < 4; ++j) { const f32x4 g = *(const f32x4*)(gpost + 4 * lane + 256 * j), gt = *(const f32x4*)(mt + 4 * lane + 256 * j);
                x[j] = x[j] + gt * (t[j] * rstd * g); *(f32x4*)(xd + 4 * lane + 256 * j) = x[j]; }
        }
        if (want_h) {
            float ss = 0.f;
#pragma unroll
            for (int j = 0; j < 4; ++j) ss += x[j].x * x[j].x + x[j].y * x[j].y + x[j].z * x[j].z + x[j].w * x[j].w;
            const float rstd = rsqrtf(wave_sum(ss) * (1.f / D) + EPS);
            const float* mh = modH + (size_t)mrow * 6144;
#pragma unroll
            for (int j = 0; j < 4; ++j) { const f32x4 g = *(const f32x4*)(gpre + 4 * lane + 256 * j), sh = *(const f32x4*)(mh + sh_off + 4 * lane + 256 * j), sc = *(const f32x4*)(mh + sc_off + 4 * lane + 256 * j);
                const f32x4 h = (x[j] * rstd * g) * (sc + 1.f) + sh;
                u32x2 o; o.x = pk2(h.x, h.y); o.y = pk2(h.z, h.w); *(u32x2*)(H + (size_t)row * D + 4 * lane + 256 * j) = o; }
        }
    }
}

__device__ __forceinline__ int scan_cid(int b, int dir, int s) { return (s < 4) ? (512 + b * 4 + (dir ? 3 - s : s)) : (b * 64 + (dir ? 63 - (s - 4) : (s - 4))); }

constexpr int G_LR = 0, G_SEG = 8192, G_CUM = 10240, G_TOT = 43008, G_T0 = 43520;
struct GlaIn { u32x4 zdec, qv, kv, vv0, vv1, og0, og1; };
template <bool G3> __device__ __forceinline__ GlaIn gla_load(const bf16_t* Z, int cid, int h, int tid) {
    GlaIn r; const int r0 = cid * 64, t = tid >> 3, q8 = tid & 7; const bf16_t* zr = Z + (size_t)(r0 + t) * NIN;
    r.zdec = *(const u32x4*)(Z + (size_t)(r0 + ((tid >> 2) & 63)) * NIN + OFF_DEC + (tid & 3) * 8);
    r.kv = *(const u32x4*)(zr + OFF_K + h * 64 + q8 * 8);
    r.vv0 = *(const u32x4*)(zr + OFF_V + h * 128 + q8 * 16); r.vv1 = *(const u32x4*)(zr + OFF_V + h * 128 + q8 * 16 + 8);
    if (G3) { r.qv = *(const u32x4*)(zr + OFF_Q + h * 64 + q8 * 8); r.og0 = *(const u32x4*)(zr + OFF_OG + h * 128 + q8 * 16); r.og1 = *(const u32x4*)(zr + OFF_OG + h * 128 + q8 * 16 + 8); }
    else { r.qv = r.kv; r.og0 = r.kv; r.og1 = r.kv; }
    return r;
}
__device__ __forceinline__ void gla_decays(LAS unsigned char* L, const u32x4& zdec, const float (&w)[16], float bias, int tid) {
    LAS float* LR = (LAS float*)(L + G_LR); LAS float* SEG = (LAS float*)(L + G_SEG); LAS float* CUM = (LAS float*)(L + G_CUM); LAS float* TOT = (LAS float*)(L + G_TOT);
    if (tid < 256) { const int t = tid >> 2, q = tid & 3;
#pragma unroll
        for (int i = 0; i < 8; ++i) LR[t * 32 + q * 8 + i] = BFE(zdec, i); }
    __syncthreads();
    const int d = tid >> 8, k = tid & 63, tq = (tid >> 6) & 3;
    float la[16];
#pragma unroll
    for (int i = 0; i < 16; ++i) { const LAS float* lr = LR + (tq * 16 + i) * 32 + d * 16; float logit = bias;
#pragma unroll
        for (int r = 0; r < 16; ++r) logit += lr[r] * w[r];
        la[i] = (fminf(logit, 0.f) - __logf(1.f + __expf(-fabsf(logit)))) * (1.f / 16.f); }
    if (d == 0) {
#pragma unroll
        for (int i = 1; i < 16; ++i) la[i] += la[i - 1];
        SEG[(0 * 4 + tq) * 64 + k] = la[15];
    } else {
#pragma unroll
        for (int i = 14; i >= 0; --i) la[i] += la[i + 1];
        SEG[(1 * 4 + tq) * 64 + k] = la[0];
    }
    __syncthreads();
    float off = 0.f, tot = 0.f;
#pragma unroll
    for (int q = 0; q < 4; ++q) { const float sv = SEG[(d * 4 + q) * 64 + k]; tot += sv; if (d == 0 ? (q < tq) : (q > tq)) off += sv; }
#pragma unroll
    for (int i = 0; i < 16; ++i) CUM[(d * 64 + tq * 16 + i) * 64 + k] = la[i] + off;
    if (tq == 0) TOT[d * 64 + k] = tot;
    __syncthreads();
}
__device__ __forceinline__ void gla_vn(LAS bf16_t* VN, const u32x4& v0, const u32x4& v1, int tid) {
    const int t = tid >> 3, vq = tid & 7;
    *(LAS u32x4*)(VN + t * 160 + vq * 16) = v0; *(LAS u32x4*)(VN + t * 160 + vq * 16 + 8) = v1;
}
#define GLA_PHASE_CONSTS() \
    const int tid = tid_opaque(), lane = tid & 63, wave = tid >> 6, r = lane & 31, hi = lane >> 5; \
    const bf16_t* Z = (const bf16_t*)(p.ws + WS_A); \
    float w[16]; float bias; \
    { const int d = tid >> 8, k = tid & 63; \
      _Pragma("unroll") for (int rr = 0; rr < 16; ++rr) w[rr] = p.in[I_WDEC][(((size_t)l * 2 + d) * 16 + rr) * 256 + h * 64 + k]; \
      bias = p.in[I_BDEC][((size_t)l * 2 + d) * 256 + h * 64 + k]; }

__device__ __forceinline__ void gla_g1_loop(const Params& p, LAS unsigned char* L, int l, int j0, int G, int nitems) {
    if (j0 >= nitems) return;
    const int h = j0 & 3;
    GLA_PHASE_CONSTS();
    LAS float* CUM = (LAS float*)(L + G_CUM); LAS float* TOT = (LAS float*)(L + G_TOT);
    LAS bf16_t* KEF = (LAS bf16_t*)(L + G_T0); LAS bf16_t* KEB = (LAS bf16_t*)(L + G_T0 + 12288); LAS bf16_t* VN = (LAS bf16_t*)(L + G_T0 + 24576);
    GlaIn cur = gla_load<false>(Z, j0 >> 2, h, tid);
    for (int j = j0; j < nitems; j += G) {
        const int cid = j >> 2;
        GlaIn nxt = cur; if (j + G < nitems) nxt = gla_load<false>(Z, (j + G) >> 2, h, tid);
        gla_decays(L, cur.zdec, w, bias, tid);
        { const int t = tid >> 3, kq = tid & 7; float ef[8], eb[8];
#pragma unroll
          for (int i = 0; i < 8; ++i) { const int k = kq * 8 + i; const float kval = BFE(cur.kv, i);
              ef[i] = kval * __expf(TOT[k] - CUM[t * 64 + k]); eb[i] = kval * __expf(TOT[64 + k] - CUM[(64 + t) * 64 + k]); }
          u32x4 o; o.x = pk2(ef[0], ef[1]); o.y = pk2(ef[2], ef[3]); o.z = pk2(ef[4], ef[5]); o.w = pk2(ef[6], ef[7]); *(LAS u32x4*)(KEF + t * 96 + kq * 8) = o;
          o.x = pk2(eb[0], eb[1]); o.y = pk2(eb[2], eb[3]); o.z = pk2(eb[4], eb[5]); o.w = pk2(eb[6], eb[7]); *(LAS u32x4*)(KEB + t * 96 + kq * 8) = o; }
        gla_vn(VN, cur.vv0, cur.vv1, tid);
        __syncthreads();
        const int dvb = wave & 3, dkb = wave >> 2;
        f32x16 accf = ZERO16, accb = ZERO16;
        mma64_tt(accf, KEF, 96, dkb * 32, VN, 160, dvb * 32, lane); mma64_tt(accb, KEB, 96, dkb * 32, VN, 160, dvb * 32, lane);
        bf16_t* US = (bf16_t*)(p.ws + WS_B);
        bf16_t* uf = US + ((size_t)((cid * 4 + h) * 2 + 0) * 128 + dvb * 32 + r) * 64 + dkb * 32 + 4 * hi;
        bf16_t* ub = US + ((size_t)((cid * 4 + h) * 2 + 1) * 128 + dvb * 32 + r) * 64 + dkb * 32 + 4 * hi;
#pragma unroll
        for (int g = 0; g < 4; ++g) { u32x2 o; o.x = pk2(accf[4 * g], accf[4 * g + 1]); o.y = pk2(accf[4 * g + 2], accf[4 * g + 3]); *(u32x2*)(uf + 8 * g) = o;
            o.x = pk2(accb[4 * g], accb[4 * g + 1]); o.y = pk2(accb[4 * g + 2], accb[4 * g + 3]); *(u32x2*)(ub + 8 * g) = o; }
        if (tid < 128) ((float*)(p.ws + WS_DEC))[(size_t)((cid * 4 + h) * 2 + (tid >> 6)) * 64 + (tid & 63)] = __expf(TOT[tid]);
        __syncthreads();
        cur = nxt;
    }
}

__device__ __forceinline__ void gla_g2(const Params& p, int item) {
    const int gid = item * NTHREADS + tid_opaque(), dk4 = gid & 15, dv = (gid >> 4) & 127, seq = gid >> 11, dir = seq & 1, h = (seq >> 1) & 3, b = seq >> 3;
    bf16_t* US = (bf16_t*)(p.ws + WS_B); const float* DEC = (const float*)(p.ws + WS_DEC);
    float s0 = 0.f, s1 = 0.f, s2 = 0.f, s3 = 0.f;
    for (int sb = 0; sb < 68; sb += 17) {
        u32x2 u[17]; f32x4 d[17];
#pragma unroll
        for (int i = 0; i < 17; ++i) { const int cid = scan_cid(b, dir, sb + i); const size_t tile = (size_t)((cid * 4 + h) * 2 + dir);
            u[i] = *(const u32x2*)(US + (tile * 128 + dv) * 64 + dk4 * 4); d[i] = *(const f32x4*)(DEC + tile * 64 + dk4 * 4); }
#pragma unroll
        for (int i = 0; i < 17; ++i) { const int cid = scan_cid(b, dir, sb + i); const size_t tile = (size_t)((cid * 4 + h) * 2 + dir);
            u32x2 o; o.x = pk2(s0, s1); o.y = pk2(s2, s3); *(u32x2*)(US + (tile * 128 + dv) * 64 + dk4 * 4) = o;
            s0 = s0 * d[i].x + bflo(u[i].x); s1 = s1 * d[i].y + bfhi(u[i].x); s2 = s2 * d[i].z + bflo(u[i].y); s3 = s3 * d[i].w + bfhi(u[i].y); }
    }
}

__device__ __forceinline__ void gla_g3_loop(const Params& p, LAS unsigned char* L, int l, int j0, int G, int nitems) {
    if (j0 >= nitems) return;
    const int h = j0 & 3;
    GLA_PHASE_CONSTS();
    LAS float* CUM = (LAS float*)(L + G_CUM);
    LAS bf16_t* QF = (LAS bf16_t*)(L + G_T0); LAS bf16_t* KF = (LAS bf16_t*)(L + G_T0 + 9216); LAS bf16_t* QB = (LAS bf16_t*)(L + G_T0 + 18432); LAS bf16_t* KB = (LAS bf16_t*)(L + G_T0 + 27648);
    LAS bf16_t* VN = (LAS bf16_t*)(L + G_T0 + 36864); LAS bf16_t* AF = (LAS bf16_t*)(L + G_T0 + 57344); LAS bf16_t* AB = (LAS bf16_t*)(L + G_T0 + 66560);
    LAS float* OST = (LAS float*)L;
    float gg[16];
#pragma unroll
    for (int i = 0; i < 16; ++i) gg[i] = p.in[I_GGLA][l * 128 + (tid & 7) * 16 + i];
    GlaIn cur = gla_load<true>(Z, j0 >> 2, h, tid);
    for (int j = j0; j < nitems; j += G) {
        const int cid = j >> 2, r0 = cid * 64;
        GlaIn nxt = cur; if (j + G < nitems) nxt = gla_load<true>(Z, (j + G) >> 2, h, tid);
        gla_decays(L, cur.zdec, w, bias, tid);
        { const int t = tid >> 3, kq = tid & 7;
          float qf[8], kf[8], qb[8], kb[8];
#pragma unroll
          for (int i = 0; i < 8; ++i) { const int k = kq * 8 + i; const float q = BFE(cur.qv, i) * 0.125f, kk = BFE(cur.kv, i), bw = CUM[t * 64 + k], cw = CUM[(64 + t) * 64 + k];
              qf[i] = q * __expf(bw); kf[i] = kk * __expf(-bw); qb[i] = q * __expf(cw); kb[i] = kk * __expf(-cw); }
          u32x4 o;
          o.x = pk2(qf[0], qf[1]); o.y = pk2(qf[2], qf[3]); o.z = pk2(qf[4], qf[5]); o.w = pk2(qf[6], qf[7]); *(LAS u32x4*)(QF + t * 72 + kq * 8) = o;
          o.x = pk2(kf[0], kf[1]); o.y = pk2(kf[2], kf[3]); o.z = pk2(kf[4], kf[5]); o.w = pk2(kf[6], kf[7]); *(LAS u32x4*)(KF + t * 72 + kq * 8) = o;
          o.x = pk2(qb[0], qb[1]); o.y = pk2(qb[2], qb[3]); o.z = pk2(qb[4], qb[5]); o.w = pk2(qb[6], qb[7]); *(LAS u32x4*)(QB + t * 72 + kq * 8) = o;
          o.x = pk2(kb[0], kb[1]); o.y = pk2(kb[2], kb[3]); o.z = pk2(kb[4], kb[5]); o.w = pk2(kb[6], kb[7]); *(LAS u32x4*)(KB + t * 72 + kq * 8) = o; }
        gla_vn(VN, cur.vv0, cur.vv1, tid);
        __syncthreads();
        {
          const int bw = wave >> 2, ib = wave & 1, jb = (wave >> 1) & 1;
          f32x16 acc = ZERO16;
          const bool live = bw ? (jb >= ib) : (jb <= ib);
          if (live) { if (bw) mma64(acc, QB + (ib * 32 + r) * 72 + 8 * hi, KB + (jb * 32 + r) * 72 + 8 * hi); else mma64(acc, QF + (ib * 32 + r) * 72 + 8 * hi, KF + (jb * 32 + r) * 72 + 8 * hi); }
          LAS bf16_t* AT = bw ? AB : AF; const int jj = jb * 32 + r;
#pragma unroll
          for (int reg = 0; reg < 16; ++reg) { const int i = ib * 32 + ACC_ROW(reg, hi); const bool keep = bw ? (jj >= i) : (jj <= i); AT[i * 72 + jj] = (bf16_t)f2bf(keep ? acc[reg] : 0.f); } }
        __syncthreads();
        const int tb = wave & 1, dvb = wave >> 1;
        f32x16 acc = ZERO16;
        { const bf16_t* US = (const bf16_t*)(p.ws + WS_B);
          const bf16_t* sF = US + ((size_t)((cid * 4 + h) * 2 + 0) * 128 + dvb * 32 + r) * 64 + 8 * hi; const bf16_t* sB = US + ((size_t)((cid * 4 + h) * 2 + 1) * 128 + dvb * 32 + r) * 64 + 8 * hi;
          mma64(acc, QF + (tb * 32 + r) * 72 + 8 * hi, sF); mma64(acc, QB + (tb * 32 + r) * 72 + 8 * hi, sB);
          mma64_rt(acc, AF + (tb * 32 + r) * 72 + 8 * hi, VN, 160, dvb * 32, lane); mma64_rt(acc, AB + (tb * 32 + r) * 72 + 8 * hi, VN, 160, dvb * 32, lane); }
#pragma unroll
        for (int reg = 0; reg < 16; ++reg) OST[(tb * 32 + ACC_ROW(reg, hi)) * 132 + dvb * 32 + r] = acc[reg];
        __syncthreads();
        { const int t = tid >> 3, part = tid & 7; float o[16]; float ss = 0.f;
#pragma unroll
          for (int i = 0; i < 16; ++i) { o[i] = OST[t * 132 + part * 16 + i]; ss += o[i] * o[i]; }
          ss += __shfl_xor(ss, 1); ss += __shfl_xor(ss, 2); ss += __shfl_xor(ss, 4);
          const float rstd = rsqrtf(ss * (1.f / 128.f) + EPS);
          bf16_t* Y = (bf16_t*)(p.ws + WS_HY) + (size_t)(r0 + t) * D + h * 128 + part * 16;
          float y[16];
#pragma unroll
          for (int i = 0; i < 8; ++i) { const float z0 = BFE(cur.og0, i), z1 = BFE(cur.og1, i);
              y[i] = o[i] * rstd * gg[i] * (z0 * __builtin_amdgcn_rcpf(1.f + __expf(-z0))); y[8 + i] = o[8 + i] * rstd * gg[8 + i] * (z1 * __builtin_amdgcn_rcpf(1.f + __expf(-z1))); }
          u32x4 wv; wv.x = pk2(y[0], y[1]); wv.y = pk2(y[2], y[3]); wv.z = pk2(y[4], y[5]); wv.w = pk2(y[6], y[7]); *(u32x4*)Y = wv;
          wv.x = pk2(y[8], y[9]); wv.y = pk2(y[10], y[11]); wv.z = pk2(y[12], y[13]); wv.w = pk2(y[14], y[15]); *(u32x4*)(Y + 8) = wv; }
        __syncthreads();
        cur = nxt;
    }
}

constexpr int R_UB = 0, R_UF = 9216, R_AA = 25600, R_BX = 58368;
struct RgIn { u32x4 z0, z1, z2, z3, zg; };
template <bool FINAL> __device__ __forceinline__ RgIn rg_load(const bf16_t* Z, int cid, int head, int tid) {
    RgIn r; const int t = tid >> 3, cq = tid & 7, ch0 = head * 64 + cq * 8, r0 = cid * 64;
    int pos, len, lbase;
    if (cid < 512) { pos = t; len = 64; lbase = r0; } else { const int n = (cid - 512) & 3; pos = n * 64 + t; len = 256; lbase = r0 - n * 64; }
    const u32x4 zero = (u32x4){0u, 0u, 0u, 0u};
    const bf16_t* zp = Z + (size_t)(lbase + pos) * NIN + OFF_RX + ch0;
    r.z0 = (pos - 1 >= 0) ? *(const u32x4*)(zp - NIN) : zero;
    r.z1 = *(const u32x4*)zp;
    r.z2 = (pos + 1 < len) ? *(const u32x4*)(zp + NIN) : zero;
    r.z3 = (pos + 2 < len) ? *(const u32x4*)(zp + 2 * NIN) : zero;
    r.zg = FINAL ? *(const u32x4*)(Z + (size_t)(r0 + t) * NIN + OFF_RG + ch0) : zero;
    return r;
}
template <bool FINAL>
__device__ __forceinline__ void rg_loop(const Params& p, LAS unsigned char* L, int l, int j0, int G, int nitems) {
    if (j0 >= nitems) return;
    const int head = j0 & 3;
    const int tid = tid_opaque(), lane = tid & 63, wave = tid >> 6, r = lane & 31, hi = lane >> 5;
    const bf16_t* Z = (const bf16_t*)(p.ws + WS_A);
    LAS bf16_t* UB = (LAS bf16_t*)(L + R_UB); LAS float* UF = (LAS float*)(L + R_UF); LAS float* AA = (LAS float*)(L + R_AA); LAS float* BX = (LAS float*)(L + R_BX);
    float bc[8], wc0[8], wc1[8], wc2[8], wc3[8];
    { const int ch0 = head * 64 + (tid & 7) * 8;
#pragma unroll
      for (int i = 0; i < 8; ++i) { bc[i] = p.in[I_BCONV][l * 256 + ch0 + i]; wc0[i] = p.in[I_WCONV][((size_t)l * 4 + 0) * 256 + ch0 + i]; wc1[i] = p.in[I_WCONV][((size_t)l * 4 + 1) * 256 + ch0 + i];
          wc2[i] = p.in[I_WCONV][((size_t)l * 4 + 2) * 256 + ch0 + i]; wc3[i] = p.in[I_WCONV][((size_t)l * 4 + 3) * 256 + ch0 + i]; } }
    const int tb = wave & 1, ob = (wave >> 1) & 1, dirw = wave >> 2;
    bf16x8 fA[4], fX[4];
    { const bf16_t* WRG = (const bf16_t*)(p.ws + WS_WRG);
      const bf16_t* bA = WRG + ((((size_t)(l * 2 + dirw) * 2 + 0) * 4 + head) * 64 + ob * 32 + r) * 64 + 8 * hi;
      const bf16_t* bXw = WRG + ((((size_t)(l * 2 + dirw) * 2 + 1) * 4 + head) * 64 + ob * 32 + r) * 64 + 8 * hi;
#pragma unroll
      for (int k = 0; k < 4; ++k) { fA[k] = *(const bf16x8*)(bA + 16 * k); fX[k] = *(const bf16x8*)(bXw + 16 * k); } }
    const int chw = ob * 32 + r, gch = head * 64 + chw;
    const float ba = p.in[I_BRGA][(l * 2 + dirw) * 256 + gch], bx_ = p.in[I_BRGX][(l * 2 + dirw) * 256 + gch], lam = p.in[I_RGLAM][(l * 2 + dirw) * 256 + gch];
    const float sp = fmaxf(-lam, 0.f) + log1pf(__expf(-fabsf(lam)));
    RgIn cur = rg_load<FINAL>(Z, j0 >> 2, head, tid);
    for (int j = j0; j < nitems; j += G) {
        const int cid = j >> 2, r0 = cid * 64;
        RgIn nxt = cur; if (j + G < nitems) nxt = rg_load<FINAL>(Z, (j + G) >> 2, head, tid);
        float h0 = 0.f;
        if (FINAL && tid < 128) h0 = ((const float*)(p.ws + WS_HST))[(size_t)(cid * 2 + (tid >> 6)) * 256 + head * 64 + (tid & 63)];
        { const int t = tid >> 3, cq = tid & 7; float u[8];
#pragma unroll
          for (int i = 0; i < 8; ++i) u[i] = bc[i] + wc0[i] * BFE(cur.z0, i) + wc1[i] * BFE(cur.z1, i) + wc2[i] * BFE(cur.z2, i) + wc3[i] * BFE(cur.z3, i);
          u32x4 o; o.x = pk2(u[0], u[1]); o.y = pk2(u[2], u[3]); o.z = pk2(u[4], u[5]); o.w = pk2(u[6], u[7]); *(LAS u32x4*)(UB + t * 72 + cq * 8) = o;
          *(LAS f32x4*)(UF + t * 64 + cq * 8) = (f32x4){u[0], u[1], u[2], u[3]}; *(LAS f32x4*)(UF + t * 64 + cq * 8 + 4) = (f32x4){u[4], u[5], u[6], u[7]}; }
        __syncthreads();
        { const LAS bf16_t* aU = UB + (tb * 32 + r) * 72 + 8 * hi;
          f32x16 accA = ZERO16, accX = ZERO16;
#pragma unroll
          for (int k = 0; k < 4; ++k) { const bf16x8 av = ldv(aU + 16 * k); accA = __builtin_amdgcn_mfma_f32_32x32x16_bf16(av, fA[k], accA, 0, 0, 0); accX = __builtin_amdgcn_mfma_f32_32x32x16_bf16(av, fX[k], accX, 0, 0, 0); }
#pragma unroll
          for (int reg = 0; reg < 16; ++reg) { const int tt = tb * 32 + ACC_ROW(reg, hi);
              const float rr = sigmoidf_(accA[reg] + ba), ii = sigmoidf_(accX[reg] + bx_), loga = -8.f * rr * sp, a = __expf(loga), x2 = 2.f * loga;
              const float om = (x2 > -0.25f) ? -x2 * (1.f + 0.5f * x2 * (1.f + (1.f / 3.f) * x2 * (1.f + 0.25f * x2 * (1.f + 0.2f * x2)))) : 1.f - __expf(x2), mult = __builtin_amdgcn_sqrtf(om);
              AA[(dirw * 64 + tt) * 64 + chw] = a; BX[(dirw * 64 + tt) * 64 + chw] = mult * ii * UF[tt * 64 + chw]; } }
        __syncthreads();
        if (tid < 128) { const int dir = tid >> 6, ch = tid & 63;
            if (!FINAL) { float hh = 0.f, P = 1.f;
#pragma unroll 8
                for (int s = 0; s < 64; ++s) { const int t = dir ? 63 - s : s; const float a = AA[(dir * 64 + t) * 64 + ch]; hh = a * hh + BX[(dir * 64 + t) * 64 + ch]; P *= a; }
                float* RGS = (float*)(p.ws + WS_RGS) + (size_t)(((cid * 4 + head) * 2 + dir) * 2) * 64 + ch; RGS[0] = P; RGS[64] = hh;
            } else { float hh = h0;
#pragma unroll 8
                for (int s = 0; s < 64; ++s) { const int t = dir ? 63 - s : s; hh = AA[(dir * 64 + t) * 64 + ch] * hh + BX[(dir * 64 + t) * 64 + ch]; BX[(dir * 64 + t) * 64 + ch] = hh; } } }
        __syncthreads();
        if (FINAL) { const int t = tid >> 3, cq = tid & 7; float y[8];
#pragma unroll
            for (int i = 0; i < 8; ++i) { const float hs = BX[t * 64 + cq * 8 + i] + BX[(64 + t) * 64 + cq * 8 + i], z = BFE(cur.zg, i);
                const float yy = 0.7978845608028654f * (z + 0.044715f * z * z * z), ge = z * (1.f - __builtin_amdgcn_rcpf(1.f + __expf(2.f * yy))); y[i] = hs * ge; }
            u32x4 wv; wv.x = pk2(y[0], y[1]); wv.y = pk2(y[2], y[3]); wv.z = pk2(y[4], y[5]); wv.w = pk2(y[6], y[7]);
            *(u32x4*)((bf16_t*)(p.ws + WS_HY) + (size_t)(r0 + t) * D + 768 + head * 64 + cq * 8) = wv;
            __syncthreads(); }
        cur = nxt;
    }
}
__device__ __forceinline__ void rg_r2(const Params& p, int item) {
    const int gid = item * NTHREADS + tid_opaque(), ch = gid & 255, dir = (gid >> 8) & 1, b = gid >> 9, head = ch >> 6, c = ch & 63;
    const float* RGS = (const float*)(p.ws + WS_RGS); float* HST = (float*)(p.ws + WS_HST);
    float hh = 0.f;
#pragma unroll 4
    for (int s = 0; s < 68; ++s) { const int cid = scan_cid(b, dir, s); const float* q = RGS + (size_t)(((cid * 4 + head) * 2 + dir) * 2) * 64 + c;
        HST[(size_t)(cid * 2 + dir) * 256 + ch] = hh; hh = q[0] * hh + q[64]; }
}

__device__ __forceinline__ void fourier_tables(LAS unsigned char* L) {
    LAS bf16_t* CM = (LAS bf16_t*)(L + TAB_OFF); LAS bf16_t* SM = (LAS bf16_t*)(L + TAB_OFF + 9216); LAS float* COST = (LAS float*)(L + TAB_OFF + 18432);
    for (int i = tid_opaque(); i < 4096; i += NTHREADS) { COST[i] = cospif((float)i * (1.f / 2048.f)); const int rr = i >> 6, c = i & 63; const float a = (float)((rr * c) & 63) * (1.f / 32.f);
        CM[rr * 72 + c] = (bf16_t)f2bf(cospif(a)); SM[rr * 72 + c] = (bf16_t)f2bf(sinpif(a)); }
    __syncthreads();
}
__device__ __forceinline__ void fourier_f1(const Params& p, LAS unsigned char* L, int b, int g, int tab) {
    const int tid = tid_opaque(), lane = tid & 63, wave = tid >> 6, r = lane & 31, hi = lane >> 5;
    const bf16_t* Z = (const bf16_t*)(p.ws + WS_A); bf16_t* FZ = (bf16_t*)(p.ws + WS_FZ);
    const LAS bf16_t* CM = (const LAS bf16_t*)(L + TAB_OFF); const LAS bf16_t* SM = (const LAS bf16_t*)(L + TAB_OFF + 9216); const LAS float* COST = (const LAS float*)(L + TAB_OFF + 18432);
    const int set = wave >> 2, wl = wave & 3;
    LAS bf16_t* X = (LAS bf16_t*)(L + set * 27648); LAS bf16_t* AT = X + 4608; LAS bf16_t* BT = X + 9216;
    for (int it = 0; it < 4; ++it) {
#pragma unroll
        for (int s = 0; s < 2; ++s) { const int ta = tab * 8 + it * 2 + s, tb = tid >> 3, cq = tid & 7;
            *(LAS u32x4*)((LAS bf16_t*)(L + s * 27648) + tb * 72 + cq * 8) = *(const u32x4*)(Z + (size_t)(b * 4096 + 64 * tb + ta) * NIN + OFF_F + g * 64 + cq * 8); }
        __syncthreads();
        { const int tbb = wl & 1, mb = wl >> 1; f32x16 aC = ZERO16, aS = ZERO16;
          const LAS bf16_t* aX = X + (tbb * 32 + r) * 72 + 8 * hi;
          mma64(aC, aX, CM + (mb * 32 + r) * 72 + 8 * hi); mma64(aS, aX, SM + (mb * 32 + r) * 72 + 8 * hi);
          const int m = mb * 32 + r;
#pragma unroll
          for (int q = 0; q < 4; ++q) { u32x2 o; o.x = pk2(aC[4 * q], aC[4 * q + 1]); o.y = pk2(aC[4 * q + 2], aC[4 * q + 3]); *(LAS u32x2*)(AT + m * 72 + tbb * 32 + 8 * q + 4 * hi) = o;
              o.x = pk2(-aS[4 * q], -aS[4 * q + 1]); o.y = pk2(-aS[4 * q + 2], -aS[4 * q + 3]); *(LAS u32x2*)(BT + m * 72 + tbb * 32 + 8 * q + 4 * hi) = o; } }
        __syncthreads();
        { const int kab = wl & 1, mb = wl >> 1; f32x16 zr = ZERO16, z1 = ZERO16, z2 = ZERO16;
          const LAS bf16_t* aC = CM + (kab * 32 + r) * 72 + 8 * hi; const LAS bf16_t* aS = SM + (kab * 32 + r) * 72 + 8 * hi;
          const LAS bf16_t* bA = AT + (mb * 32 + r) * 72 + 8 * hi; const LAS bf16_t* bB = BT + (mb * 32 + r) * 72 + 8 * hi;
          mma64(zr, aC, bA); mma64(zr, aS, bB); mma64(z1, aC, bB); mma64(z2, aS, bA);
          const int ta = tab * 8 + it * 2 + set, m = mb * 32 + r;
#pragma unroll
          for (int reg = 0; reg < 16; ++reg) { const int ka = kab * 32 + ACC_ROW(reg, hi), idx = (ta * ka) & 4095; const float cs = COST[idx], sn = COST[(idx + 3072) & 4095];
              const float re = zr[reg], im = z1[reg] - z2[reg];
              bf16_t* o = FZ + ((((size_t)(b * 4 + g) * 64 + ta) * 64 + ka) * 2) * 64 + m;
              o[0] = (bf16_t)f2bf(re * cs + im * sn); o[64] = (bf16_t)f2bf(im * cs - re * sn); } }
    }
    __syncthreads();
}
__device__ __forceinline__ void fourier_f2(const Params& p, LAS unsigned char* L, int b, int g, int kap) {
    const int tid = tid_opaque(), lane = tid & 63, wave = tid >> 6, r = lane & 31, hi = lane >> 5;
    const bf16_t* FZ = (const bf16_t*)(p.ws + WS_FZ);
    const LAS bf16_t* CM = (const LAS bf16_t*)(L + TAB_OFF); const LAS bf16_t* SM = (const LAS bf16_t*)(L + TAB_OFF + 9216);
#pragma unroll
    for (int j = 0; j < 4; ++j) { const int piece = tid + NTHREADS * j, set = piece >> 10, pp = piece & 1023, ta = pp >> 4, ch = pp & 15, ka = kap * 2 + set;
        *(LAS u32x4*)((LAS bf16_t*)(L + set * 20480) + ta * 160 + ch * 8) = *(const u32x4*)(FZ + (((size_t)(b * 4 + g) * 64 + ta) * 64 + ka) * 128 + ch * 8); }
    __syncthreads();
    { const int set = wave >> 2, wl = wave & 3, kbb = wl & 1, mb = wl >> 1, ka = kap * 2 + set;
      const LAS bf16_t* ZN = (const LAS bf16_t*)(L + set * 20480);
      f32x16 acc = ZERO16;
      mma64_rt(acc, CM + (kbb * 32 + r) * 72 + 8 * hi, ZN, 160, mb * 32, lane); mma64_rt(acc, SM + (kbb * 32 + r) * 72 + 8 * hi, ZN, 160, 64 + mb * 32, lane);
      bf16_t* Y = (bf16_t*)(p.ws + WS_HY);
#pragma unroll
      for (int reg = 0; reg < 16; ++reg) { const int kb = kbb * 32 + ACC_ROW(reg, hi); Y[(size_t)(b * 4096 + ka + 64 * kb) * D + 512 + g * 64 + mb * 32 + r] = (bf16_t)f2bf(acc[reg] * (1.f / 512.f)); } }
    __syncthreads();
}
__device__ __forceinline__ void fourier_ctx(const Params& p, LAS unsigned char* L, int b, int g, int mq) {
    const int tid = tid_opaque();
    const bf16_t* Z = (const bf16_t*)(p.ws + WS_A);
    LAS bf16_t* XC = (LAS bf16_t*)L; LAS float* AC = (LAS float*)(L + 32768); LAS float* BC = (LAS float*)(L + 49152); const LAS float* COST = (const LAS float*)(L + TAB_OFF + 18432);
#pragma unroll
    for (int j = 0; j < 4; ++j) { const int piece = tid + NTHREADS * j, t = piece >> 3, cq = piece & 7;
        *(LAS u32x4*)(XC + t * 64 + cq * 8) = *(const u32x4*)(Z + (size_t)(NLAT + b * 256 + t) * NIN + OFF_F + g * 64 + cq * 8); }
    __syncthreads();
    const int mi = tid & 15, m = mq * 16 + mi, t0 = tid >> 4;
    for (int j = 0; j < 8; ++j) { const int t = t0 + 32 * j; float a = 0.f, bi = 0.f;
        for (int c = 0; c < 64; ++c) { const float x = bf1(XC[t * 64 + c]); const int idx = ((m * c) & 63) * 64; a += x * COST[idx]; bi -= x * COST[(idx + 3072) & 4095]; }
        AC[t * 16 + mi] = a; BC[t * 16 + mi] = bi; }
    __syncthreads();
    float acc[8];
#pragma unroll
    for (int j = 0; j < 8; ++j) acc[j] = 0.f;
    for (int t = 0; t < 256; ++t) { const float a = AC[t * 16 + mi], bi = BC[t * 16 + mi];
#pragma unroll
        for (int j = 0; j < 8; ++j) { const int k = t0 + 32 * j, idx = ((k * t) & 255) * 16; acc[j] += COST[idx] * a + COST[(idx + 3072) & 4095] * bi; } }
    bf16_t* Y = (bf16_t*)(p.ws + WS_HY);
#pragma unroll
    for (int j = 0; j < 8; ++j) { const int k = t0 + 32 * j; Y[(size_t)(NLAT + b * 256 + k) * D + 512 + g * 64 + m] = (bf16_t)f2bf(acc[j] * (1.f / 128.f)); }
    __syncthreads();
}

#define RLX_AGENT __ATOMIC_RELAXED, __HIP_MEMORY_SCOPE_AGENT
#define XB_TMO      128
#define XB_XCNT(j)  (256  + 64 * (j))
#define XB_XSUB(j)  (1280 + 64 * (j))
#define XB_XGEN(j)  (2304 + 64 * (j))
#define XB_TOP      3328
#define XB_TOPGEN   3392
#define XCD_BAR_WORDS 3456
#define XB_SPIN_CAP (1u << 18)

__device__ __forceinline__ unsigned xb_ld(unsigned* p)              { return __hip_atomic_load(p, __ATOMIC_RELAXED, __HIP_MEMORY_SCOPE_AGENT); }
__device__ __forceinline__ unsigned xb_add(unsigned* p, unsigned v) { return __hip_atomic_fetch_add(p, v, __ATOMIC_RELAXED, __HIP_MEMORY_SCOPE_AGENT); }
__device__ __forceinline__ unsigned xb_xcc_id() { return (unsigned)__builtin_amdgcn_s_getreg((3 << 11) | 20) & 0xFu; }
#define XB_SPIN(cond, bar) do { unsigned _sp = 0; while (cond) { __builtin_amdgcn_s_sleep(1); \
    if ((++_sp & 255u) == 0u) { if (xb_ld(&(bar)[XB_TMO])) break; if (_sp > XB_SPIN_CAP) { atomicAdd(&(bar)[XB_TMO], 1u); break; } } } } while (0)

struct XcdBarrier {
    unsigned* bar; unsigned x;
    volatile LAS unsigned* st;
};

__device__ __forceinline__ XcdBarrier xcd_barrier_post(unsigned* bar, volatile LAS unsigned* st) {
    XcdBarrier b; b.bar = bar; b.x = xb_xcc_id(); b.st = st;
    if (threadIdx.x == 0) (void)xb_add(&bar[XB_XCNT(b.x)], 1u);
    return b;
}
__device__ __forceinline__ void xcd_barrier_complete(unsigned* bar, unsigned x, unsigned& nloc, unsigned& nx) {
    const unsigned G = gridDim.x * gridDim.y * gridDim.z;
    unsigned sum, cnt, mine, sp = 0u;
    for (;;) {
        sum = 0u; cnt = 0u; mine = 0u;
#pragma unroll
        for (unsigned j = 0; j < 16; ++j) { const unsigned c = xb_ld(&bar[XB_XCNT(j)]); sum += c; cnt += (c > 0u) ? 1u : 0u; mine = (j == x) ? c : mine; }
        if (sum == G) break;
        __builtin_amdgcn_s_sleep(1);
        if ((++sp & 255u) == 0u) { if (xb_ld(&bar[XB_TMO])) break; if (sp > XB_SPIN_CAP) { atomicAdd(&bar[XB_TMO], 1u); break; } }
    }
    nloc = mine > 0u ? mine : 1u; nx = cnt > 0u ? cnt : 1u;
}

__device__ __forceinline__ void xcd_barrier(const XcdBarrier& b) {
    asm volatile("s_waitcnt vmcnt(0)" ::: "memory");
    __syncthreads();
    if (threadIdx.x == 0) {
        unsigned* bar = b.bar;
        __builtin_amdgcn_s_waitcnt(0);
        unsigned nloc = b.st[0], nx = b.st[1];
        if (nloc == 0u) { xcd_barrier_complete(bar, b.x, nloc, nx); b.st[0] = nloc; b.st[1] = nx; }
        const unsigned old = xb_add(&bar[XB_XSUB(b.x)], 1u);
        const unsigned gen = old / nloc;
        if (old + 1u == (gen + 1u) * nloc) {
            __builtin_amdgcn_fence(__ATOMIC_RELEASE, "agent");
            asm volatile("s_waitcnt vmcnt(0)" ::: "memory");
            const unsigned og = xb_add(&bar[XB_TOP], 1u);
            const unsigned tg = og / nx;
            if (og + 1u == (tg + 1u) * nx) xb_add(&bar[XB_TOPGEN], 1u);
            else XB_SPIN(xb_ld(&bar[XB_TOPGEN]) == tg, bar);
            __builtin_amdgcn_fence(__ATOMIC_ACQUIRE, "agent");
            xb_add(&bar[XB_XGEN(b.x)], 1u);
            asm volatile("s_waitcnt vmcnt(0)" ::: "memory");
        } else {
            XB_SPIN(xb_ld(&bar[XB_XGEN(b.x)]) == gen, bar);
            __builtin_amdgcn_fence(__ATOMIC_ACQUIRE, "agent");
            asm volatile("s_waitcnt vmcnt(0)" ::: "memory");
        }
    }
    __syncthreads();
}
constexpr int NPHASES = 2 + 9 * DEPTH;
#ifndef PROBE_DUP
#define PROBE_DUP 0
#endif
__global__ void __launch_bounds__(NTHREADS, 2) mega_fwd(Params p) {
    extern __shared__ __attribute__((aligned(16))) unsigned char lds_raw[];
    LAS unsigned char* L = (LAS unsigned char*)lds_raw;
    cg::grid_group grid = cg::this_grid();
    if (threadIdx.x < 64) ((volatile LAS unsigned*)(L + MISC_OFF))[threadIdx.x] = 0u;
    __syncthreads();
    XcdBarrier xbar = xcd_barrier_post((unsigned*)(p.ws + WS_CTL), (volatile LAS unsigned*)(L + MISC_OFF));
    unsigned char* ws = p.ws;
    const float* MOD = (const float*)(ws + WS_MOD);
    const int G = gridDim.x, bx = blockIdx.x;
    for (int ph = p.ph_lo; ph < p.ph_hi; ++ph) {
        if (ph == 0) { phase_prologue(p, L); if (PROBE_DUP & 64) { __syncthreads(); phase_prologue(p, L); } }
        else if (ph != 1) {
            const int l = (ph - 2) / 9, sub = (ph - 2) % 9; const bool last = (l == DEPTH - 1);
            const int mrows = last ? NLAT : MROWS, nchunk = last ? 512 : NCHUNK;
            const float* modl = MOD + (size_t)l * 9 * 6144;
            const float* xlat = (l == 0) ? p.in[I_X] : p.out; const float* xctx = (l == 0) ? p.in[I_CTX] : (const float*)(ws + WS_XC);
            const int dupbit = (sub == 0) ? 1 : (sub == 4) ? 2 : (sub == 6) ? 4 : (sub == 7) ? 8 : (sub == 1) ? 16 : (sub == 3) ? 32 : 0;
            for (int rep = 0; rep < ((PROBE_DUP & dupbit) ? 2 : 1); ++rep)
            switch (sub) {
            case 0: { pg8::Gemm g{(const bf16_t*)(ws + WS_HY), (const bf16_t*)(ws + WS_WIN) + (size_t)l * NINP * D, MROWS, NINP, D}; pg8::StaticOrder S; S.init(MROWS, NINP, G, bx);
                      pg8::EpiBf16N E{(bf16_t*)(ws + WS_A), NIN, NIN}; pg8::gemm_phase<pg8::EpiBf16N, pg8::StaticOrder, true, true>(L, g, S, E); } break;
            case 1: { fourier_tables(L);
                      for (int rp = 0; rp < ((PROBE_DUP & 256) ? 2 : 1); ++rp) for (int j = bx; j < 256; j += G) fourier_f1(p, L, j >> 5, (j >> 3) & 3, j & 7);
                      if (!last) for (int j = (bx + 128) % G; j < 128; j += G) fourier_ctx(p, L, j >> 4, (j >> 2) & 3, j & 3);
                      for (int rp = 0; rp < ((PROBE_DUP & 1024) ? 2 : 1); ++rp) gla_g1_loop(p, L, l, bx, G, NCHUNK * 4);
                      for (int rp = 0; rp < ((PROBE_DUP & 2048) ? 2 : 1); ++rp) rg_loop<false>(p, L, l, (bx + 128) % G, G, NCHUNK * 4); } break;
            case 2: { fourier_tables(L);
                      for (int j = bx; j < 256; j += G) gla_g2(p, j);
                      for (int j = bx; j < 8; j += G) rg_r2(p, j);
                      for (int j = bx; j < 1024; j += G) fourier_f2(p, L, j >> 7, (j >> 5) & 3, j & 31); } break;
            case 3: { const int nG = nchunk * 4;
                      for (int rp = 0; rp < ((PROBE_DUP & 4096) ? 2 : 1); ++rp) gla_g3_loop(p, L, l, bx, G, nG);
                      for (int rp = 0; rp < ((PROBE_DUP & 8192) ? 2 : 1); ++rp) rg_loop<true>(p, L, l, (bx + 128) % G, G, nG); } break;
            case 4: { pg8::Gemm g{(const bf16_t*)(ws + WS_HY), (const bf16_t*)(ws + WS_WOUT) + (size_t)l * D * D, mrows, D, D}; pg8::StaticOrder S; S.init(mrows, D, G, bx);
                      pg8::EpiBf16N E{(bf16_t*)(ws + WS_B), D, D}; pg8::gemm_phase<pg8::EpiBf16N, pg8::StaticOrder, true, true>(L, g, S, E); } break;
            case 5: break;
            case 6: { pg8::Gemm g{(const bf16_t*)(ws + WS_HY), (const bf16_t*)(ws + WS_WGU) + (size_t)l * 2 * DFF * D, mrows, 2 * DFF, D}; pg8::StaticOrder S; S.init(mrows, 2 * DFF, G, bx);
                      pg8::EpiSwiGLU E{(bf16_t*)(ws + WS_A), DFF}; pg8::gemm_phase<pg8::EpiSwiGLU, pg8::StaticOrder, true, true>(L, g, S, E); } break;
            case 7: { pg8::Gemm g{(const bf16_t*)(ws + WS_A), (const bf16_t*)(ws + WS_WDN) + (size_t)l * D * DFF, mrows, D, DFF}; pg8::StaticOrder S; S.init(mrows, D, G, bx);
                      pg8::EpiBf16N E{(bf16_t*)(ws + WS_B), D, D}; pg8::gemm_phase<pg8::EpiBf16N, pg8::StaticOrder, true, true>(L, g, S, E); } break;
            default: break;
            }
        }
        {
            const int l = (ph < 2) ? 0 : (ph - 2) / 9, sub = (ph < 2) ? -1 : (ph - 2) % 9; const bool last = (l == DEPTH - 1);
            if (ph == 1 || sub == 5 || sub == 8) {
                const bool has_t = (ph != 1), r2 = (sub == 8);
                const float* modl = MOD + (size_t)l * 9 * 6144;
                const float* xlat = (l == 0 && !r2) ? p.in[I_X] : p.out; const float* xctx = (l == 0 && !r2) ? p.in[I_CTX] : (const float*)(ws + WS_XC);
                const int lh = r2 ? (last ? l : l + 1) : l;
                rows_phase(p, has_t, (last && has_t) ? NLAT : MROWS, xlat, xctx, (const bf16_t*)(ws + WS_B), p.in[r2 ? I_GPOSTFFN : I_GPOSTMIX] + l * D, modl, r2 ? 5120 : 2048,
                           !(r2 && last), p.in[(sub == 5) ? I_GPREFFN : I_GPREMIX] + lh * D, MOD + (size_t)lh * 9 * 6144, (sub == 5) ? 3072 : 0, (sub == 5) ? 4096 : 1024);
            }
        }
        if (ph + 1 < p.ph_hi) { if (ph == 0) grid.sync(); else { xcd_barrier(xbar); if (PROBE_DUP & 128) xcd_barrier(xbar); } }
    }
}

#ifndef MK_SPLIT
#define MK_SPLIT 0
#endif
extern "C" void kernel_launch(void* const* d_in, const int* in_sizes, int n_in, void* d_out, int out_size, void* d_ws, size_t ws_size, hipStream_t stream) {
    static int grid = 0;
    if (grid == 0) {
        int dev = 0, cus = 0, per_cu = 0;
        if (n_in != 25 || ws_size < WS_CTL + CTL_BYTES) { fprintf(stderr, "kernel_launch: unexpected inputs (n_in %d, ws %zu)\n", n_in, ws_size); grid = -1; return; }
        hipGetDevice(&dev); hipDeviceGetAttribute(&cus, hipDeviceAttributeMultiprocessorCount, dev);
        if (hipFuncSetAttribute((const void*)mega_fwd, hipFuncAttributeMaxDynamicSharedMemorySize, LDS_BYTES) != hipSuccess) fprintf(stderr, "kernel_launch: hipFuncSetAttribute failed\n");
        if (hipOccupancyMaxActiveBlocksPerMultiprocessor(&per_cu, (const void*)mega_fwd, NTHREADS, LDS_BYTES) != hipSuccess || per_cu < 1) { fprintf(stderr, "kernel_launch: occupancy query gave %d\n", per_cu); per_cu = 1; }
        (void)hipGetLastError();
        grid = cus * 1;
    }
    if (grid < 0) return;
    if (hipMemsetAsync((char*)d_ws + WS_CTL, 0, CTL_BYTES, stream) != hipSuccess) fprintf(stderr, "kernel_launch: memset failed\n");
    Params p{};
    for (int i = 0; i < 25; ++i) p.in[i] = (const float*)d_in[i];
    p.out = (float*)d_out; p.ws = (unsigned char*)d_ws;
#if MK_SPLIT
    for (int ph = 0; ph < NPHASES; ++ph) { p.ph_lo = ph; p.ph_hi = ph + 1; hipLaunchKernelGGL(mega_fwd, dim3(grid), dim3(NTHREADS), LDS_BYTES, stream, p); }
#else
    p.ph_lo = 0; p.ph_hi = NPHASES;
    void* args[] = {&p};
    hipError_t e = hipLaunchCooperativeKernel((const void*)mega_fwd, dim3(grid), dim3(NTHREADS), args, LDS_BYTES, stream);
    if (e != hipSuccess) fprintf(stderr, "kernel_launch: cooperative launch failed: %s (grid %d)\n", hipGetErrorString(e), grid);
#endif
}
```
